# Optimizing an MI355X kernel written in HIP

```python
import math
import jax, jax.numpy as jnp
from jax import lax
import numpy as np

D_MODEL = 2048
BATCH = 2
SEQ = 8192
DEPTH = 2

HEAD_DIM = 128
RET_HEADS = 6
RET_W = RET_HEADS * HEAD_DIM
RET_CHUNK = 128
DIFF_HEADS = 4
DIFF_QK = HEAD_DIM // 2
DIFF_W = DIFF_HEADS * HEAD_DIM
Q_BLOCK = 128
LRU_W = 768
LRU_BLOCKS = 8
LRU_BW = LRU_W // LRU_BLOCKS
CONV_W = 4
LRU_C = 8.0
D_MIX = RET_W + DIFF_W + LRU_W
SPLIT_SIZES = (RET_W, RET_W, RET_W, RET_W,
               DIFF_W, DIFF_W, DIFF_W, DIFF_W,
               LRU_W, LRU_W)
D_IN = sum(SPLIT_SIZES)
ROPE_THETA = 10000.0
EPS = 1e-6

kernel_name = "hybrid_retention_diffattn_rglru_block"


def rms_norm(x, g=None):
    x32 = x.astype(jnp.float32)
    y = x32 * lax.rsqrt(jnp.mean(x32 * x32, axis=-1, keepdims=True) + EPS)
    if g is not None:
        y = y * g.astype(jnp.float32)
    return y.astype(x.dtype)


def rope(x, positions, inv_freq):
    ang = positions.astype(jnp.float32)[..., None] * inv_freq
    cos = jnp.cos(ang)[:, :, None, :].astype(x.dtype)
    sin = jnp.sin(ang)[:, :, None, :].astype(x.dtype)
    x1, x2 = jnp.split(x, 2, axis=-1)
    return jnp.concatenate([x1 * cos - x2 * sin, x2 * cos + x1 * sin], axis=-1)


def retention(q, k, v, positions):
    B, S, H, D = q.shape
    dt = q.dtype
    inv = 1.0 / (ROPE_THETA ** jnp.linspace(0.0, 1.0, D // 2, dtype=jnp.float32))
    q = rope(q, positions, inv)
    k = rope(k, positions, inv) * (D ** -0.5)
    log_g = jnp.log1p(-jnp.power(2.0, -5.0 - jnp.arange(H, dtype=jnp.float32)))
    C = RET_CHUNK
    N = S // C
    idx = jnp.arange(C, dtype=jnp.float32)
    rel = idx[:, None] - idx[None, :]
    intra_decay = jnp.where(rel[None] >= 0,
                            jnp.exp(jnp.maximum(rel, 0.0)[None] * log_g[:, None, None]),
                            0.0).astype(dt)
    qc = q.reshape(B, N, C, H, D)
    kc = k.reshape(B, N, C, H, D)
    vc = v.reshape(B, N, C, H, D)
    scores = jnp.einsum('bnihd,bnjhd->bnhij', qc, kc) * intra_decay
    o_intra = jnp.einsum('bnhij,bnjhe->bnihe', scores, vc)
    k_w = jnp.exp((C - 1.0 - idx)[:, None] * log_g[None, :]).astype(dt)
    kv = jnp.einsum('bnjhd,bnjhe->nbhde', kc * k_w[:, :, None], vc)
    chunk_decay = jnp.exp(C * log_g)[None, :, None, None].astype(kv.dtype)

    def step(state, kv_n):
        return state * chunk_decay + kv_n, state

    _, s_prev = lax.scan(step, jnp.zeros_like(kv[0]), kv)
    q_w = jnp.exp((idx + 1.0)[:, None] * log_g[None, :]).astype(dt)
    o_cross = jnp.einsum('bnihd,nbhde->bnihe', qc * q_w[:, :, None], s_prev)
    return (o_intra + o_cross).reshape(B, S, H, D)


def diff_attention(q, k, v, positions, lam):
    B, S, H, _, DQ = q.shape
    inv = 1.0 / (ROPE_THETA ** (jnp.arange(0, DQ, 2, dtype=jnp.float32) / DQ))
    q = rope(q.reshape(B, S, H * 2, DQ), positions, inv).reshape(B, S, H, 2, DQ) * (DQ ** -0.5)
    k = rope(k.reshape(B, S, H * 2, DQ), positions, inv).reshape(B, S, H, 2, DQ)
    kpos = jnp.arange(S)

    def block(i):
        qb = lax.dynamic_slice_in_dim(q, i * Q_BLOCK, Q_BLOCK, axis=1)
        s = jnp.einsum('bqhcd,bkhcd->bhcqk', qb, k).astype(jnp.float32)
        qpos = i * Q_BLOCK + jnp.arange(Q_BLOCK)
        s = jnp.where(kpos[None, :] <= qpos[:, None], s, -jnp.inf)
        p = jax.nn.softmax(s, axis=-1)
        w = p[:, :, 0] - lam * p[:, :, 1]
        return jnp.einsum('bhqk,bkhe->bqhe', w.astype(v.dtype), v)

    o = lax.map(block, jnp.arange(S // Q_BLOCK))
    return jnp.transpose(o, (1, 0, 2, 3, 4)).reshape(B, S, H, v.shape[-1])


def rg_lru(x, conv_w, conv_b, wa, ba, wx, bx, lam):
    B, S, W = x.shape
    xp = jnp.pad(x, ((0, 0), (CONV_W - 1, 0), (0, 0)))
    xc = conv_b + xp[:, 0:S] * conv_w[0]
    for j in range(1, CONV_W):
        xc = xc + xp[:, j:j + S] * conv_w[j]
    xb = xc.reshape(B, S, LRU_BLOCKS, LRU_BW)
    r = jax.nn.sigmoid(jnp.einsum('bsnk,nkj->bsnj', xb, wa).reshape(B, S, W) + ba)
    i = jax.nn.sigmoid(jnp.einsum('bsnk,nkj->bsnj', xb, wx).reshape(B, S, W) + bx)
    log_a = (LRU_C * r.astype(jnp.float32)) * jax.nn.log_sigmoid(lam.astype(jnp.float32))
    a = jnp.exp(log_a)
    mult = jnp.sqrt(-jnp.expm1(2.0 * log_a))
    b = mult * (i * xc).astype(jnp.float32)

    def combine(left, right):
        a1, b1 = left
        a2, b2 = right
        return a1 * a2, a2 * b1 + b2

    _, h = lax.associative_scan(combine, (a, b), axis=1)
    return h.astype(x.dtype)


def setup_inputs(seed: int = 0) -> dict:
    key = jax.random.key(seed)
    ks = jax.random.split(key, 20)
    f32 = jnp.float32
    x = jax.random.normal(ks[0], (BATCH, SEQ, D_MODEL), f32)
    positions = jnp.broadcast_to(jnp.arange(SEQ, dtype=jnp.int32), (BATCH, SEQ))
    pre_norm_g = 1.0 + 0.05 * jax.random.normal(ks[1], (DEPTH, D_MODEL), f32)
    w_in = jax.random.normal(ks[2], (DEPTH, D_MODEL, D_IN), f32) * (D_MODEL ** -0.5)
    diff_lambda_q1 = 0.1 * jax.random.normal(ks[3], (DEPTH, DIFF_QK), f32)
    diff_lambda_k1 = 0.1 * jax.random.normal(ks[4], (DEPTH, DIFF_QK), f32)
    diff_lambda_q2 = 0.1 * jax.random.normal(ks[5], (DEPTH, DIFF_QK), f32)
    diff_lambda_k2 = 0.1 * jax.random.normal(ks[6], (DEPTH, DIFF_QK), f32)
    diff_subln_g = 1.0 + 0.05 * jax.random.normal(ks[7], (DEPTH, HEAD_DIM), f32)
    lru_conv_w = jax.random.normal(ks[8], (DEPTH, CONV_W, LRU_W), f32) * (CONV_W ** -0.5)
    lru_conv_b = 0.01 * jax.random.normal(ks[9], (DEPTH, LRU_W), f32)
    lru_wa = jax.random.normal(ks[10], (DEPTH, LRU_BLOCKS, LRU_BW, LRU_BW), f32) * (LRU_BW ** -0.5)
    lru_ba = 0.01 * jax.random.normal(ks[11], (DEPTH, LRU_W), f32)
    lru_wx = jax.random.normal(ks[12], (DEPTH, LRU_BLOCKS, LRU_BW, LRU_BW), f32) * (LRU_BW ** -0.5)
    lru_bx = 0.01 * jax.random.normal(ks[13], (DEPTH, LRU_W), f32)
    u = jax.random.uniform(ks[14], (DEPTH, LRU_W), f32, minval=0.9, maxval=0.999)
    s = u ** (1.0 / LRU_C)
    lru_lambda = jnp.log(s) - jnp.log1p(-s)
    w_out = jax.random.normal(ks[15], (DEPTH, D_MIX, D_MODEL), f32) * (D_MIX ** -0.5)
    post_norm_g = 1.0 + 0.05 * jax.random.normal(ks[16], (DEPTH, D_MODEL), f32)
    return {"x": x, "positions": positions, "pre_norm_g": pre_norm_g, "w_in": w_in,
            "diff_lambda_q1": diff_lambda_q1, "diff_lambda_k1": diff_lambda_k1,
            "diff_lambda_q2": diff_lambda_q2, "diff_lambda_k2": diff_lambda_k2,
            "diff_subln_g": diff_subln_g, "lru_conv_w": lru_conv_w, "lru_conv_b": lru_conv_b,
            "lru_wa": lru_wa, "lru_ba": lru_ba, "lru_wx": lru_wx, "lru_bx": lru_bx,
            "lru_lambda": lru_lambda, "w_out": w_out, "post_norm_g": post_norm_g}


def reference(x, positions, pre_norm_g, w_in, diff_lambda_q1, diff_lambda_k1,
              diff_lambda_q2, diff_lambda_k2, diff_subln_g, lru_conv_w, lru_conv_b,
              lru_wa, lru_ba, lru_wx, lru_bx, lru_lambda, w_out, post_norm_g):
    B, S, _ = x.shape
    split_idx = [int(v) for v in np.cumsum(SPLIT_SIZES)[:-1]]
    for l in range(DEPTH):
        h = rms_norm(x, pre_norm_g[l])
        proj = jnp.einsum('bsd,de->bse', h, w_in[l])
        (rq, rk, rv, rg, dq, dk, dv, dg, lx, lg) = jnp.split(proj, split_idx, axis=-1)

        ro = retention(rq.reshape(B, S, RET_HEADS, HEAD_DIM),
                       rk.reshape(B, S, RET_HEADS, HEAD_DIM),
                       rv.reshape(B, S, RET_HEADS, HEAD_DIM), positions)
        ret_out = rms_norm(ro).reshape(B, S, RET_W) * jax.nn.silu(rg)

        lam_init = 0.8 - 0.6 * math.exp(-0.3 * l)
        lam = (jnp.exp(jnp.sum(diff_lambda_q1[l] * diff_lambda_k1[l]).astype(jnp.float32))
               - jnp.exp(jnp.sum(diff_lambda_q2[l] * diff_lambda_k2[l]).astype(jnp.float32))
               + lam_init)
        do = diff_attention(dq.reshape(B, S, DIFF_HEADS, 2, DIFF_QK),
                            dk.reshape(B, S, DIFF_HEADS, 2, DIFF_QK),
                            dv.reshape(B, S, DIFF_HEADS, HEAD_DIM), positions, lam)
        diff_out = (rms_norm(do, diff_subln_g[l]) * (1.0 - lam_init)).reshape(B, S, DIFF_W) * jax.nn.silu(dg)

        lru_out = rg_lru(lx, lru_conv_w[l], lru_conv_b[l], lru_wa[l], lru_ba[l],
                         lru_wx[l], lru_bx[l], lru_lambda[l]) * jax.nn.silu(lg)

        mixed = jnp.concatenate([ret_out, diff_out, lru_out], axis=-1)
        y = jnp.einsum('bse,ed->bsd', mixed, w_out[l])
        x = x + rms_norm(y, post_norm_g[l])
    return x
```

```cpp
#include <hip/hip_runtime.h>
#include <hip/hip_cooperative_groups.h>
#include <cstdio>
#include <cstdint>
namespace cg = cooperative_groups;
namespace pg8 {
#define PG8_LAS __attribute__((address_space(3)))
typedef unsigned short bf16_t;
typedef short bf16x8 __attribute__((ext_vector_type(8)));
typedef float f32x4 __attribute__((ext_vector_type(4)));
typedef unsigned u32x4 __attribute__((ext_vector_type(4)));
constexpr int BM = 256, BK = 64, HALF = 128, HTB = HALF * BK * 2  , STAGE_BYTES = 8 * HTB, NXCD = 8, WGM = 4;

__host__ __device__ __forceinline__ int lds_byte(int r, int c) { const int st = (r >> 4) * 2 + (c >> 5), rr = r & 15, cc = c & 31, ob = rr * 64 + cc * 2; return st * 1024 + (ob ^ (((ob >> 9) & 1) << 5)); }
__host__ __device__ __forceinline__ void stage_rc(int b, int& R, int& C) { const int st = b / 1024, sb = b % 1024, swz = sb ^ (((sb >> 9) & 1) << 5); R = (st >> 1) * 16 + swz / 64; C = (st & 1) * 32 + (swz % 64) / 2; }
__host__ __device__ __forceinline__ int perm32(int rho) { const int n = rho >> 4, i = rho & 15; return 8 * (i >> 2) + 4 * n + (i & 3); }

struct Unit { int pm, pn; };
struct Gemm { const bf16_t* A; const bf16_t* Bt; int M, N, K; };

struct StaticOrder {
    int nM, nN, nwg, G, c;
    __host__ __device__ void init(int M, int N, int G_, int c_) { nM = M / BM; nN = N / BM; nwg = nM * nN; G = G_; c = c_; }
    __host__ __device__ bool next(int i, Unit& u) const {
        const long L = (long)i * G + c; if (L >= nwg) return false;
        int wgid = (int)L; { const int q = nwg / NXCD, r = nwg % NXCD, xcd = wgid % NXCD, off = wgid / NXCD; wgid = (xcd < r ? xcd * (q + 1) : r * (q + 1) + (xcd - r) * q) + off; }
        const int nig = WGM * nN, gid = wgid / nig, fm = gid * WGM, gsz = (nM - fm) < WGM ? (nM - fm) : WGM;
        u.pm = fm + ((wgid % nig) % gsz); u.pn = (wgid % nig) / gsz; return true;
    }
    __device__ __forceinline__ void a_ready(const Unit&) const {}
    __device__ __forceinline__ void done(const Unit&) const {}
};
__device__ __forceinline__ unsigned cvt_pk_bf16(float lo, float hi) { unsigned r; asm volatile("v_cvt_pk_bf16_f32 %0, %1, %2" : "=v"(r) : "v"(lo), "v"(hi)); return r; }
typedef float f32x2 __attribute__((ext_vector_type(2)));
typedef unsigned u32x4 __attribute__((ext_vector_type(4)));
struct EpiProj {
    static constexpr bool PERM = true, AFTER_DRAIN = false;
    bf16_t* O; const float* rstd; const float* cosR; const float* sinR; const float* cosD; const float* sinD;
    __device__ __forceinline__ void operator()(const f32x4 (&acc)[2][2][4][2], const Unit& u, int wr, int wc, int fr, int fq) const {
        const int row0 = u.pm * BM + wr * 64 + fr; const int colt = u.pn * BM;
        int mode = 0; float sc = 1.f;
        if (colt < 768) { mode = 1; } else if (colt < 1536) { mode = 1; sc = 0.08838834764831845f; }
        else if (colt >= 3072 && colt < 3584) { mode = 2; sc = 0.125f * 1.4426950408889634f; } else if (colt >= 3584 && colt < 4096) { mode = 2; }
        const int colw = colt + wc * 32 + 8 * fq;
#pragma unroll
        for (int ai = 0; ai < 2; ++ai)
#pragma unroll
            for (int m = 0; m < 4; ++m) { const int row = row0 + ai * HALF + m * 16; const float rs = rstd[row] * sc;
#pragma unroll
                for (int bj = 0; bj < 2; ++bj) { const int col0 = colw + bj * HALF; f32x4 v0 = acc[ai][bj][m][0] * rs, v1 = acc[ai][bj][m][1] * rs;
                    if (mode != 0) {
                        f32x4 cs, sn;
                        if (mode == 1) { const int i0 = (col0 & 127) >> 1; cs = *(const f32x4*)(cosR + (size_t)row * 64 + i0); sn = *(const f32x4*)(sinR + (size_t)row * 64 + i0); }
                        else { const int i0 = (col0 & 63) >> 1; cs = *(const f32x4*)(cosD + (size_t)row * 32 + i0); sn = *(const f32x4*)(sinD + (size_t)row * 32 + i0); }
                        f32x4 w0, w1;
                        w0[0] = v0[0] * cs[0] - v0[1] * sn[0]; w0[1] = v0[1] * cs[0] + v0[0] * sn[0];
                        w0[2] = v0[2] * cs[1] - v0[3] * sn[1]; w0[3] = v0[3] * cs[1] + v0[2] * sn[1];
                        w1[0] = v1[0] * cs[2] - v1[1] * sn[2]; w1[1] = v1[1] * cs[2] + v1[0] * sn[2];
                        w1[2] = v1[2] * cs[3] - v1[3] * sn[3]; w1[3] = v1[3] * cs[3] + v1[2] * sn[3];
                        v0 = w0; v1 = w1;
                    }
                    u32x4 w; w.x = cvt_pk_bf16(v0[0], v0[1]); w.y = cvt_pk_bf16(v0[2], v0[3]); w.z = cvt_pk_bf16(v1[0], v1[1]); w.w = cvt_pk_bf16(v1[2], v1[3]);
                    *(u32x4*)(O + (size_t)row * 6656 + col0) = w; } }
    }
};
struct EpiY {
    static constexpr bool PERM = true, AFTER_DRAIN = false;
    bf16_t* Y; float* ssq;
    __device__ __forceinline__ void operator()(const f32x4 (&acc)[2][2][4][2], const Unit& u, int wr, int wc, int fr, int fq) const {
        const int row0 = u.pm * BM + wr * 64 + fr; const int colw = u.pn * BM + wc * 32 + 8 * fq;
#pragma unroll
        for (int ai = 0; ai < 2; ++ai)
#pragma unroll
            for (int m = 0; m < 4; ++m) { const int row = row0 + ai * HALF + m * 16; float s = 0.f;
#pragma unroll
                for (int bj = 0; bj < 2; ++bj) { const f32x4 v0 = acc[ai][bj][m][0], v1 = acc[ai][bj][m][1];
                    s += (v0[0] * v0[0] + v0[1] * v0[1]) + (v0[2] * v0[2] + v0[3] * v0[3]) + (v1[0] * v1[0] + v1[1] * v1[1]) + (v1[2] * v1[2] + v1[3] * v1[3]);
                    u32x4 w; w.x = cvt_pk_bf16(v0[0], v0[1]); w.y = cvt_pk_bf16(v0[2], v0[3]); w.z = cvt_pk_bf16(v1[0], v1[1]); w.w = cvt_pk_bf16(v1[2], v1[3]);
                    *(u32x4*)(Y + (size_t)row * 2048 + colw + bj * HALF) = w; }
                s += __shfl_xor(s, 16); s += __shfl_xor(s, 32);
                if (fq == 0) unsafeAtomicAdd(ssq + row, s); }
    }
};
template <class Epi, class Sched, bool ALIGN_EPI = false, bool SP2 = false>
__device__ __forceinline__ void gemm_phase(PG8_LAS unsigned char* lds, const Gemm g, const Sched& S, const Epi& E) {
    int tid = threadIdx.x; asm volatile("" : "+v"(tid)); const int wid = __builtin_amdgcn_readfirstlane(tid >> 6), lane = tid & 63, wr = wid >> 2, wc = wid & 3, fr = lane & 15, fq = lane >> 4;
    const int K = g.K, nt = K / BK;
    unsigned voffA[2], voffB[2];
#pragma unroll
    for (int i = 0; i < 2; ++i) { int R, C; stage_rc(tid * 16 + i * 8192, R, C); const int Rb = Epi::PERM ? ((R & ~31) + perm32(R & 31)) : R;
        voffA[i] = (unsigned)(R * K + C) * 2u; voffB[i] = (unsigned)(Rb * K + C) * 2u; }
    const size_t kstep = (size_t)(BK * 2);
    const size_t hstep = (size_t)HALF * K * 2;
    const size_t tstep = 2 * hstep;
    const unsigned ldsw = (unsigned)wid * 1024u;
    const int aoff = lds_byte(wr * 64 + fr, fq * 8), boff = lds_byte(wc * 32 + fr, fq * 8);
#define PG8_SA(b, h) (((b) * 2 + (h)) * HTB)
#define PG8_SB(b, h) ((4 + (b) * 2 + (h)) * HTB)
#define PG8_STAGE(bufoff, gbase, voff) do { _Pragma("unroll") for (int _i = 0; _i < 2; ++_i) \
        __builtin_amdgcn_global_load_lds((const unsigned*)((const char*)(gbase) + (voff)[_i]), (PG8_LAS unsigned*)(lds + (bufoff) + ldsw + _i * 8192), 16, 0, 0); } while (0)
#define PG8_LDA(dst, b, h) do { _Pragma("unroll") for (int m = 0; m < 4; ++m) _Pragma("unroll") for (int k = 0; k < 2; ++k) dst[m][k] = *(const PG8_LAS bf16x8*)(lds + PG8_SA(b, h) + aoff + m * 2048 + k * 1024); } while (0)
#define PG8_LDB(dst, b, h) do { _Pragma("unroll") for (int n = 0; n < 2; ++n) _Pragma("unroll") for (int k = 0; k < 2; ++k) dst[n][k] = *(const PG8_LAS bf16x8*)(lds + PG8_SB(b, h) + boff + n * 2048 + k * 1024); } while (0)
#define PG8_MMA(ai, bj, At, Bt) do { __builtin_amdgcn_s_setprio(1); _Pragma("unroll") for (int m = 0; m < 4; ++m) _Pragma("unroll") for (int n = 0; n < 2; ++n) _Pragma("unroll") for (int k = 0; k < 2; ++k) \
        acc[ai][bj][m][n] = __builtin_amdgcn_mfma_f32_16x16x32_bf16(Bt[n][k], At[m][k], acc[ai][bj][m][n], 0, 0, 0); __builtin_amdgcn_s_setprio(0); } while (0)
#define PG8_WAIT_V(n) asm volatile("s_waitcnt vmcnt(" #n ")" ::: "memory")
#define PG8_WAIT_L(n) asm volatile("s_waitcnt lgkmcnt(" #n ")" ::: "memory")
#define PG8_BAR __builtin_amdgcn_s_barrier()
#define PG8_SCHED __builtin_amdgcn_sched_barrier(0)
    Unit cur, nxt; int ui = 0;
    if (!S.next(0, cur)) return;
    f32x4 acc[2][2][4][2];
#pragma unroll
    for (int a = 0; a < 2; ++a)
#pragma unroll
        for (int b = 0; b < 2; ++b)
#pragma unroll
            for (int m = 0; m < 4; ++m)
#pragma unroll
                for (int n = 0; n < 2; ++n) acc[a][b][m][n] = (f32x4){0.f, 0.f, 0.f, 0.f};
    bf16x8 At[4][2], B0[2][2], B1[2][2];
    const char* cA = (const char*)g.A + (size_t)cur.pm * tstep; const char* cB = (const char*)g.Bt + (size_t)cur.pn * tstep;
    S.a_ready(cur);
    if constexpr (SP2) {
        PG8_STAGE(PG8_SB(0, 0), cB, voffB); PG8_STAGE(PG8_SB(0, 1), cB + hstep, voffB); PG8_STAGE(PG8_SA(0, 0), cA, voffA); PG8_STAGE(PG8_SA(0, 1), cA + hstep, voffA);
        if (wr == 1) PG8_BAR;
        PG8_WAIT_V(2); PG8_BAR;
        PG8_STAGE(PG8_SB(1, 0), cB + kstep, voffB); PG8_STAGE(PG8_SA(1, 0), cA + kstep, voffA); PG8_STAGE(PG8_SB(1, 1), cB + hstep + kstep, voffB);
        PG8_WAIT_V(6); PG8_BAR;
    } else {
        PG8_STAGE(PG8_SB(0, 0), cB, voffB); PG8_STAGE(PG8_SA(0, 0), cA, voffA); PG8_STAGE(PG8_SB(0, 1), cB + hstep, voffB); PG8_STAGE(PG8_SA(0, 1), cA + hstep, voffA);
        if (wr == 1) PG8_BAR;
        PG8_WAIT_V(4); PG8_BAR;
        PG8_STAGE(PG8_SB(1, 0), cB + kstep, voffB); PG8_STAGE(PG8_SA(1, 0), cA + kstep, voffA); PG8_STAGE(PG8_SB(1, 1), cB + hstep + kstep, voffB);
        PG8_WAIT_V(6); PG8_BAR;
    }
    for (;;) {
        const bool has_next = S.next(ui + 1, nxt);
        const char* nA = has_next ? (const char*)g.A + (size_t)nxt.pm * tstep : cA; const char* nB = has_next ? (const char*)g.Bt + (size_t)nxt.pn * tstep : cB;
        for (int t = 0; t < nt; t += 2) {
            const bool last = (t == nt - 2);
            const char* a1 = cA + (size_t)(t + 1) * kstep;
            const char* a2 = last ? nA : cA + (size_t)(t + 2) * kstep; const char* b2 = last ? nB : cB + (size_t)(t + 2) * kstep;
            const char* a3 = a2 + kstep; const char* b3 = b2 + kstep;
            if (last && has_next) S.a_ready(nxt);
            if constexpr (SP2) {
            PG8_LDB(B0, 0, 0); PG8_LDB(B1, 0, 1); PG8_SCHED; PG8_LDA(At, 0, 0); PG8_STAGE(PG8_SA(1, 1), a1 + hstep, voffA);
            PG8_WAIT_V(8); PG8_WAIT_L(0); PG8_BAR; PG8_MMA(0, 0, At, B0); PG8_MMA(0, 1, At, B1); PG8_BAR; PG8_SCHED;
            PG8_LDA(At, 0, 1); PG8_STAGE(PG8_SB(0, 0), b2, voffB); PG8_STAGE(PG8_SB(0, 1), b2 + hstep, voffB); PG8_STAGE(PG8_SA(0, 0), a2, voffA);
            PG8_WAIT_V(8); PG8_WAIT_L(0); PG8_BAR; PG8_MMA(1, 0, At, B0); PG8_MMA(1, 1, At, B1); PG8_BAR; PG8_SCHED;
            PG8_LDB(B0, 1, 0); PG8_LDB(B1, 1, 1); PG8_SCHED; PG8_LDA(At, 1, 0); PG8_STAGE(PG8_SA(0, 1), a2 + hstep, voffA);
            PG8_WAIT_V(8); PG8_WAIT_L(0); PG8_BAR; PG8_MMA(0, 0, At, B0); PG8_MMA(0, 1, At, B1); PG8_BAR; PG8_SCHED;
            PG8_LDA(At, 1, 1); PG8_STAGE(PG8_SB(1, 0), b3, voffB); PG8_STAGE(PG8_SB(1, 1), b3 + hstep, voffB); PG8_STAGE(PG8_SA(1, 0), a3, voffA);
            PG8_WAIT_V(8); PG8_WAIT_L(0); PG8_BAR; PG8_MMA(1, 0, At, B0); PG8_MMA(1, 1, At, B1); PG8_BAR; PG8_SCHED;
            } else {
            PG8_LDB(B0, 0, 0); PG8_SCHED; PG8_LDA(At, 0, 0); PG8_STAGE(PG8_SA(1, 1), a1 + hstep, voffA);
            PG8_WAIT_L(8); PG8_BAR; PG8_WAIT_L(0); PG8_MMA(0, 0, At, B0); PG8_BAR; PG8_SCHED;
            PG8_LDB(B1, 0, 1); PG8_STAGE(PG8_SB(0, 0), b2, voffB);
            PG8_BAR; PG8_WAIT_L(0); PG8_MMA(0, 1, At, B1); PG8_BAR;
            PG8_LDA(At, 0, 1); PG8_STAGE(PG8_SA(0, 0), a2, voffA);
            PG8_BAR; PG8_WAIT_L(0); PG8_MMA(1, 0, At, B0); PG8_BAR; PG8_SCHED;
            PG8_STAGE(PG8_SB(0, 1), b2 + hstep, voffB);
            PG8_WAIT_V(6); PG8_BAR; PG8_MMA(1, 1, At, B1); PG8_BAR;
            PG8_LDB(B0, 1, 0); PG8_SCHED; PG8_LDA(At, 1, 0); PG8_STAGE(PG8_SA(0, 1), a2 + hstep, voffA);
            PG8_WAIT_L(8); PG8_BAR; PG8_WAIT_L(0); PG8_MMA(0, 0, At, B0); PG8_BAR; PG8_SCHED;
            PG8_LDB(B1, 1, 1); PG8_STAGE(PG8_SB(1, 0), b3, voffB);
            PG8_BAR; PG8_WAIT_L(0); PG8_MMA(0, 1, At, B1); PG8_BAR;
            PG8_LDA(At, 1, 1); PG8_STAGE(PG8_SA(1, 0), a3, voffA);
            PG8_BAR; PG8_WAIT_L(0); PG8_MMA(1, 0, At, B0); PG8_BAR; PG8_SCHED;
            PG8_STAGE(PG8_SB(1, 1), b3 + hstep, voffB);
            PG8_WAIT_V(6); PG8_BAR; PG8_MMA(1, 1, At, B1); PG8_BAR;
            }
        }
        if constexpr (ALIGN_EPI) { if (wr == 0) PG8_BAR; }
        if constexpr (!Epi::AFTER_DRAIN) { E(acc, cur, wr, wc, fr, fq); S.done(cur); }
        if (!has_next) break;
#pragma unroll
        for (int a = 0; a < 2; ++a)
#pragma unroll
            for (int b = 0; b < 2; ++b)
#pragma unroll
                for (int m = 0; m < 4; ++m)
#pragma unroll
                    for (int n = 0; n < 2; ++n) acc[a][b][m][n] = (f32x4){0.f, 0.f, 0.f, 0.f};
        cur = nxt; cA = nA; cB = nB; ++ui;
        if constexpr (ALIGN_EPI) { if (wr == 1) PG8_BAR; }
    }
    PG8_WAIT_V(0);
    if constexpr (!ALIGN_EPI) { if (wr == 0) PG8_BAR; }
    PG8_BAR;
    if constexpr (Epi::AFTER_DRAIN) { E.fused(acc, cur, wr, wc, fr, fq, lds, wid, lane); S.done(cur); }
#undef PG8_SA
#undef PG8_SB
#undef PG8_STAGE
#undef PG8_LDA
#undef PG8_LDB
#undef PG8_MMA
#undef PG8_WAIT_V
#undef PG8_WAIT_L
#undef PG8_BAR
#undef PG8_SCHED
}
}
#define LAS __attribute__((address_space(3)))
typedef unsigned short bf16_t;
typedef short bf16x8 __attribute__((ext_vector_type(8)));
typedef short s16x4 __attribute__((ext_vector_type(4)));
typedef float f32x4 __attribute__((ext_vector_type(4)));
typedef float f32x16 __attribute__((ext_vector_type(16)));
typedef unsigned u32x4 __attribute__((ext_vector_type(4)));
constexpr int BATCH = 2, SEQ = 8192, DM = 2048, M = BATCH * SEQ, DIN = 6656;
constexpr int C_RQ = 0, C_RK = 768, C_RV = 1536, C_RG = 2304, C_DQ = 3072, C_DK = 3584, C_DV = 4096, C_DG = 4608, C_LX = 5120, C_LG = 5888;
constexpr float EPS = 1e-6f;
constexpr size_t MiB = 1u << 20;
constexpr size_t WS_SSQ = 0, WS_RSTD = 128 * 1024, WS_BAR = 256 * 1024, WS_BAR_BYTES = 16384, WS_C8 = 320 * 1024;
constexpr size_t WS_COSR = 1 * MiB, WS_SINR = 5 * MiB, WS_COSD = 9 * MiB, WS_SIND = 11 * MiB, WS_LRUW = 13 * MiB;
constexpr size_t WS_HEND = 14 * MiB, WS_AEND = 14 * MiB + 512 * 1024, WS_CARRY = 15 * MiB;
constexpr size_t WS_WIN = 16 * MiB, WS_WOUT = 68 * MiB, WS_XB = 84 * MiB, WS_PROJ = 148 * MiB, WS_KV = 356 * MiB, WS_SP = 404 * MiB, WS_HL = 428 * MiB, WS_AC = 452 * MiB, WS_END = 476 * MiB;
constexpr size_t WS_MIXED = WS_XB, WS_Y = WS_PROJ;
constexpr int LDS_BYTES = 147456, LDS_BARST = 147200;

struct Params {
    const float* x; const int* pos; const float* pre_g; const float* w_in; const float* lq1; const float* lk1; const float* lq2; const float* lk2;
    const float* subln_g; const float* conv_w; const float* conv_b; const float* wa; const float* ba; const float* wx; const float* bx; const float* lru_lam;
    const float* w_out; const float* post_g; float* out; unsigned char* ws; int ph_lo, ph_hi;
};

#define MFMA32(a, b, c) __builtin_amdgcn_mfma_f32_32x32x16_bf16((a), (b), (c), 0, 0, 0)
__device__ __forceinline__ unsigned cvtpk(float lo, float hi) { return pg8::cvt_pk_bf16(lo, hi); }
__device__ __forceinline__ float bflo(unsigned w) { return __uint_as_float(w << 16); }
__device__ __forceinline__ float bfhi(unsigned w) { return __uint_as_float(w & 0xffff0000u); }
__device__ __forceinline__ int crow(int r, int hi) { return (r & 3) + 8 * (r >> 2) + 4 * hi; }
typedef short v4i16_t __attribute__((ext_vector_type(4)));
__device__ __forceinline__ s16x4 tr_read(const LAS unsigned char* p) { return __builtin_bit_cast(s16x4, __builtin_amdgcn_ds_read_tr16_b64_v4i16((LAS v4i16_t*)p)); }
__device__ __forceinline__ bf16x8 cat8(s16x4 lo, s16x4 hi) { return __builtin_shufflevector(lo, hi, 0, 1, 2, 3, 4, 5, 6, 7); }
__device__ __forceinline__ bf16x8 pack8(const f32x16& s, int b) { u32x4 w; w.x = cvtpk(s[b], s[b + 1]); w.y = cvtpk(s[b + 2], s[b + 3]); w.z = cvtpk(s[b + 4], s[b + 5]); w.w = cvtpk(s[b + 6], s[b + 7]); return __builtin_bit_cast(bf16x8, w); }
__device__ __forceinline__ float wave_sum(float v) {
#pragma unroll
    for (int o = 1; o < 64; o <<= 1) v += __shfl_xor(v, o);
    return v;
}
__device__ __forceinline__ float fexp2(float x) { return __builtin_amdgcn_exp2f(x); }
__device__ __forceinline__ float sigm(float x) { return 1.f / (1.f + __expf(-x)); }
__device__ __forceinline__ float silu(float x) { return x / (1.f + __expf(-x)); }
__device__ __forceinline__ float ret_log2g(int h) { return log2f(1.f - exp2f(-5.f - (float)h)); }

__device__ __forceinline__ int src_col_in(int n) {
    if (n < 1536) { const int cn = n & 127; return (n - cn) + (cn >> 1) + 64 * (cn & 1); }
    if (n >= 3072 && n < 4096) { const int cn = n & 63; return (n - cn) + (cn >> 1) + 32 * (cn & 1); }
    return n;
}
__device__ __forceinline__ void p0_transpose_item(const float* W, int K, int N, bf16_t* WT, const float* gk, bool perm, LAS float* scr, int item, int lane) {
    const int nblk = N / 32, kb = item / nblk, nb = item % nblk, k0 = 64 * kb, n0 = 32 * nb;
    const int krow = lane >> 3, part = lane & 7;
    int srcc = n0 + 4 * part, dst0 = 4 * part, dstep = 1;
    if (perm && (n0 < 1536 || (n0 >= 3072 && n0 < 4096))) {
        const int H = n0 < 1536 ? 128 : 64, cn0 = n0 & (H - 1), seg = part >> 2, j4 = part & 3;
        srcc = (n0 - cn0) + (cn0 >> 1) + 4 * j4 + seg * (H >> 1); dst0 = 8 * j4 + seg; dstep = 2;
    }
#pragma unroll
    for (int i = 0; i < 8; ++i) { const int kk = 8 * i + krow; f32x4 v = *(const f32x4*)(W + (size_t)(k0 + kk) * N + srcc); if (gk) v = v * gk[k0 + kk];
        LAS float* d = scr + kk * 33 + dst0; d[0] = v[0]; d[dstep] = v[1]; d[2 * dstep] = v[2]; d[3 * dstep] = v[3]; }
    asm volatile("s_waitcnt lgkmcnt(0)" ::: "memory");
    const int c = lane & 7;
#pragma unroll
    for (int j = 0; j < 4; ++j) { const int n = (lane >> 3) + 8 * j; const LAS float* s = scr + (8 * c) * 33 + n;
        u32x4 o; o.x = cvtpk(s[0 * 33], s[1 * 33]); o.y = cvtpk(s[2 * 33], s[3 * 33]); o.z = cvtpk(s[4 * 33], s[5 * 33]); o.w = cvtpk(s[6 * 33], s[7 * 33]);
        *(u32x4*)(WT + (size_t)(n0 + n) * K + k0 + 8 * c) = o; }
    asm volatile("s_waitcnt lgkmcnt(0)" ::: "memory");
}
__device__ __forceinline__ void sincos_d(double a, float& s, float& c) {
    const double kq = rint(a * 0.63661977236758134308);
    double r = fma(-kq, 1.57079632679489655800e+00, a); r = fma(-kq, 6.12323399573676603587e-17, r);
    const int q = (int)((long long)kq & 3);
    const double r2 = r * r;
    const double sp = r * (1.0 + r2 * (-1.0 / 6.0 + r2 * (1.0 / 120.0 + r2 * (-1.0 / 5040.0 + r2 * (1.0 / 362880.0 + r2 * (-1.0 / 39916800.0 + r2 * (1.0 / 6227020800.0)))))));
    const double cp = 1.0 + r2 * (-0.5 + r2 * (1.0 / 24.0 + r2 * (-1.0 / 720.0 + r2 * (1.0 / 40320.0 + r2 * (-1.0 / 3628800.0 + r2 * (1.0 / 479001600.0))))));
    const double ss = (q & 1) ? cp : sp, cc = (q & 1) ? sp : cp;
    s = (float)((q & 2) ? -ss : ss); c = (float)(((q + 1) & 2) ? -cc : cc);
}
__device__ __forceinline__ void phase0(const Params& p, LAS unsigned char* L) {
    int tid = threadIdx.x; asm volatile("" : "+v"(tid)); const int lane = tid & 63, wave = tid >> 6;
    const int gw = blockIdx.x * 8 + wave, NGW = gridDim.x * 8, gt = blockIdx.x * 512 + tid, NT = gridDim.x * 512;
    unsigned char* ws = p.ws;
    LAS float* scr = (LAS float*)(L + wave * 16384);
    constexpr int I_IN = 32 * 208, I_OUT = 32 * 64, I_L = I_IN + I_OUT;
    for (int it = gw; it < 2 * I_L; it += NGW) {
        const int layer = it / I_L, r = it - layer * I_L;
        if (r < I_IN) p0_transpose_item(p.w_in + (size_t)layer * 2048 * DIN, 2048, DIN, (bf16_t*)(ws + WS_WIN) + (size_t)layer * DIN * 2048, p.pre_g + layer * 2048, true, scr, r, lane);
        else p0_transpose_item(p.w_out + (size_t)layer * 2048 * 2048, 2048, 2048, (bf16_t*)(ws + WS_WOUT) + (size_t)layer * 2048 * 2048, nullptr, false, scr, r - I_IN, lane);
    }
    float* rstd = (float*)(ws + WS_RSTD); bf16_t* XB = (bf16_t*)(ws + WS_XB);
    for (int m = gw; m < M; m += NGW) {
        const float* xr = p.x + (size_t)m * DM; f32x4 v[8]; float s = 0.f;
#pragma unroll
        for (int j = 0; j < 4; ++j) { v[2 * j] = *(const f32x4*)(xr + j * 512 + lane * 8); v[2 * j + 1] = *(const f32x4*)(xr + j * 512 + lane * 8 + 4);
            const f32x4 a = v[2 * j], b = v[2 * j + 1]; s += (a[0] * a[0] + a[1] * a[1]) + (a[2] * a[2] + a[3] * a[3]) + (b[0] * b[0] + b[1] * b[1]) + (b[2] * b[2] + b[3] * b[3]); }
        s = wave_sum(s);
        if (lane == 0) rstd[m] = 1.f / sqrtf(s * (1.f / DM) + EPS);
#pragma unroll
        for (int j = 0; j < 4; ++j) { const f32x4 a = v[2 * j], b = v[2 * j + 1]; u32x4 w; w.x = cvtpk(a[0], a[1]); w.y = cvtpk(a[2], a[3]); w.z = cvtpk(b[0], b[1]); w.w = cvtpk(b[2], b[3]);
            *(u32x4*)(XB + (size_t)m * DM + j * 512 + lane * 8) = w; }
    }
    float* cosR = (float*)(ws + WS_COSR); float* sinR = (float*)(ws + WS_SINR); float* cosD = (float*)(ws + WS_COSD); float* sinD = (float*)(ws + WS_SIND);
    for (int e = gt; e < M * 96; e += NT) {
        const int m = e / 96, f = e - m * 96; const double pos = (double)p.pos[m];
        float s, c;
        if (f < 64) { const double inv = exp(-((double)f / 63.0) * 9.210340371976184); sincos_d(pos * inv, s, c); cosR[(size_t)m * 64 + f] = c; sinR[(size_t)m * 64 + f] = s; }
        else { const int i = f - 64; const double inv = exp(-((double)(2 * i) / 64.0) * 9.210340371976184); sincos_d(pos * inv, s, c); cosD[(size_t)m * 32 + i] = c; sinD[(size_t)m * 32 + i] = s; }
    }
    float* ssq = (float*)(ws + WS_SSQ);
    for (int e = gt; e < 2 * M; e += NT) ssq[e] = 0.f;
    float* C8 = (float*)(ws + WS_C8);
    for (int e = gt; e < 2 * 768; e += NT) C8[e] = -8.f * log1pf(expf(-p.lru_lam[e]));
    bf16_t* LW = (bf16_t*)(ws + WS_LRUW);
    for (int e = gt; e < 2 * 2 * 8 * 96 * 96; e += NT) {
        const int k = e % 96, j = (e / 96) % 96, n = (e / 9216) % 8, gate = (e / 73728) % 2, l = e / 147456;
        const float v = (gate ? p.wx : p.wa)[(size_t)((l * 8 + n) * 96 + k) * 96 + j];
        LW[e] = (bf16_t)(cvtpk(v, 0.f) & 0xffffu);
    }
}
constexpr int AT_KP = 272, AT_VP = 320, AT_KB = 64 * AT_KP, AT_VB = 64 * AT_VP, AT_KOFF = 0, AT_VOFF = 2 * AT_KB, AT_XOFF = 0, AT_EOFF = 65536, E_PITCH = 132;
__device__ __forceinline__ float max3f(float a, float b, float c) { float r; asm("v_max3_f32 %0, %1, %2, %3" : "=v"(r) : "v"(a), "v"(b), "v"(c)); return r; }
__device__ __forceinline__ float max2f(float a, float b) { float r; asm("v_max_f32_e32 %0, %1, %2" : "=v"(r) : "v"(a), "v"(b)); return r; }
__device__ __forceinline__ float xhalf_max(float m) { auto rr = __builtin_amdgcn_permlane32_swap(__float_as_uint(m), __float_as_uint(m), false, false); return max2f(__uint_as_float(rr[0]), __uint_as_float(rr[1])); }
__device__ __forceinline__ float xhalf_sum(float m) { auto rr = __builtin_amdgcn_permlane32_swap(__float_as_uint(m), __float_as_uint(m), false, false); return __uint_as_float(rr[0]) + __uint_as_float(rr[1]); }
__device__ __forceinline__ void attn_item(LAS unsigned char* L, const bf16_t* PROJ, bf16_t* MIXED, const float* subln, int b, int h, int qb, float lam, float one_m_li) {
    int tid = threadIdx.x; asm volatile("" : "+v"(tid)); const int lane = tid & 63, wid = __builtin_amdgcn_readfirstlane(tid >> 6), l31 = lane & 31, hi = lane >> 5;
    const int c = wid >> 2, rb = wid & 3;
    const int q0 = qb * 128; const size_t rowbase = (size_t)b * SEQ;
    bf16x8 qf[4];
    { const bf16_t* qp = PROJ + (rowbase + q0 + 32 * rb + l31) * DIN + C_DQ + h * 128 + c * 64 + 8 * hi;
#pragma unroll
      for (int s = 0; s < 4; ++s) qf[s] = *(const bf16x8*)(qp + 16 * s); }
    f32x16 o[4];
#pragma unroll
    for (int e = 0; e < 4; ++e)
#pragma unroll
        for (int r = 0; r < 16; ++r) o[e][r] = 0.f;
    float m_run = 0.f, l_run = 0.f;
    const int nt = (q0 + 128) / 64;
    const bf16_t* kg = PROJ + (rowbase + (tid >> 4)) * DIN + C_DK + h * 128 + (tid & 15) * 8;
    const bf16_t* vg = kg + (C_DV - C_DK);
    const int st_k = (tid >> 4) * AT_KP + (tid & 15) * 16, st_v = (tid >> 4) * AT_VP + (tid & 15) * 16;
    u32x4 kr[2], vr[2];
#define AT_LOAD(t) { _Pragma("unroll") for (int i_ = 0; i_ < 2; ++i_) { const size_t go_ = (size_t)((t) * 64 + 32 * i_) * DIN; kr[i_] = *(const u32x4*)(kg + go_); vr[i_] = *(const u32x4*)(vg + go_); } }
#define AT_STORE(kbf, vsl) { _Pragma("unroll") for (int i_ = 0; i_ < 2; ++i_) { *(LAS u32x4*)(L + AT_KOFF + (kbf) * AT_KB + st_k + 32 * i_ * AT_KP) = kr[i_]; *(LAS u32x4*)(L + AT_VOFF + (vsl) * AT_VB + st_v + 32 * i_ * AT_VP) = vr[i_]; } }
    AT_LOAD(0); AT_STORE(0, 0); __syncthreads();
    const int g = lane >> 4, tq = (lane & 15) >> 2, tp = lane & 3;
    const int vlane = (4 * hi + tq) * AT_VP + (16 * (g & 1) + 4 * tp) * 2;
    const int klane = l31 * AT_KP + (c * 64 + 8 * hi) * 2;
    const int qi = q0 + 32 * rb + l31;
    bf16x8 pb[4];
    f32x16 s0, s1;
#define AT_QK(t_) { const int k0 = (t_) * 64; \
        const LAS unsigned char* kb = L + AT_KOFF + ((t_) & 1) * AT_KB + klane; bf16x8 ka[4], kc[4]; \
        _Pragma("unroll") for (int s = 0; s < 4; ++s) { ka[s] = *(const LAS bf16x8*)(kb + s * 32); kc[s] = *(const LAS bf16x8*)(kb + 32 * AT_KP + s * 32); } \
        _Pragma("unroll") for (int r = 0; r < 16; ++r) { s0[r] = 0.f; s1[r] = 0.f; } \
        _Pragma("unroll") for (int s = 0; s < 4; ++s) { s0 = MFMA32(ka[s], qf[s], s0); s1 = MFMA32(kc[s], qf[s], s1); } \
        if (k0 + 63 > q0 + 32 * rb) { _Pragma("unroll") for (int r = 0; r < 16; ++r) { const int key = k0 + crow(r, hi); if (key > qi) s0[r] = -INFINITY; if (key + 32 > qi) s1[r] = -INFINITY; } } \
        asm volatile("s_nop 15\n\ts_nop 7" : "+v"(s0), "+v"(s1));     \
        { float ma = max3f(s0[0], s0[1], s1[0]), mb = max3f(s0[2], s0[3], s1[1]); ma = max3f(ma, s1[2], s1[3]); \
          _Pragma("unroll") for (int r = 4; r < 16; r += 4) { ma = max3f(ma, s0[r], s0[r + 1]); mb = max3f(mb, s0[r + 2], s0[r + 3]); ma = max3f(ma, s1[r], s1[r + 1]); mb = max3f(mb, s1[r + 2], s1[r + 3]); } \
          mx = xhalf_max(max2f(ma, mb)); } }
#define AT_LDV(dst, ks_) { _Pragma("unroll") for (int e = 0; e < 4; ++e) { dst[2 * e] = tr_read(vb + (16 * (ks_)) * AT_VP + 64 * e); dst[2 * e + 1] = tr_read(vb + (16 * (ks_) + 8) * AT_VP + 64 * e); } }
#define AT_MMV(src, ks_) { _Pragma("unroll") for (int e = 0; e < 4; ++e) o[e] = MFMA32(cat8(src[2 * e], src[2 * e + 1]), pb[ks_], o[e]); }
#define AT_EXP(S, lo_) { _Pragma("unroll") for (int r = (lo_); r < (lo_) + 8; ++r) { S[r] = fexp2(S[r] - m_new); rs += S[r]; } }
    { float mx; AT_QK(0); m_run = mx; const float m_new = mx; float rs = 0.f; AT_EXP(s0, 0); AT_EXP(s0, 8); AT_EXP(s1, 0); AT_EXP(s1, 8); l_run = rs;
      pb[0] = pack8(s0, 0); pb[1] = pack8(s0, 8); pb[2] = pack8(s1, 0); pb[3] = pack8(s1, 8); }
    int vs = 1, vsp = 0;
    AT_LOAD(1); AT_STORE(1, 1); __syncthreads();
    u32x4 kr2[2], vr2[2];
#define AT_LOADS(KR, VR, t) { _Pragma("unroll") for (int i_ = 0; i_ < 2; ++i_) { const size_t go_ = (size_t)((t) * 64 + 32 * i_) * DIN; KR[i_] = *(const u32x4*)(kg + go_); VR[i_] = *(const u32x4*)(vg + go_); } }
#define AT_STORES(KR, VR, kbf, vsl) { _Pragma("unroll") for (int i_ = 0; i_ < 2; ++i_) { *(LAS u32x4*)(L + AT_KOFF + (kbf) * AT_KB + st_k + 32 * i_ * AT_KP) = KR[i_]; *(LAS u32x4*)(L + AT_VOFF + (vsl) * AT_VB + st_v + 32 * i_ * AT_VP) = VR[i_]; } }
#define AT_ITER(t_, KS, VS, KL, VL) { \
        const int vsn = vs == 2 ? 0 : vs + 1; \
        if ((t_) + 2 < nt) AT_LOADS(KL, VL, (t_) + 2); \
        const LAS unsigned char* vb = L + AT_VOFF + vsp * AT_VB + vlane; s16x4 va[8], vn[8]; \
        AT_LDV(va, 0); AT_LDV(vn, 1);     \
        float mx; AT_QK(t_); \
        const bool need = __any(mx > m_run); \
        const float m_new = max2f(m_run, mx); \
        float rs = 0.f; \
        AT_MMV(va, 0); AT_EXP(s0, 0); AT_LDV(va, 2); \
        AT_MMV(vn, 1); AT_EXP(s0, 8); AT_LDV(vn, 3); \
        AT_MMV(va, 2); AT_EXP(s1, 0); \
        AT_MMV(vn, 3); AT_EXP(s1, 8); \
        bf16x8 pn[4]; pn[0] = pack8(s0, 0); pn[1] = pack8(s0, 8); pn[2] = pack8(s1, 0); pn[3] = pack8(s1, 8); \
        asm volatile("" : "+v"(pn[0]), "+v"(pn[1]), "+v"(pn[2]), "+v"(pn[3]), "+v"(rs)); \
        if (need) { const float alpha = fexp2(m_run - m_new); l_run *= alpha; \
            _Pragma("unroll") for (int e = 0; e < 4; ++e) _Pragma("unroll") for (int r = 0; r < 16; ++r) o[e][r] *= alpha; } \
        m_run = m_new; l_run += rs; \
        pb[0] = pn[0]; pb[1] = pn[1]; pb[2] = pn[2]; pb[3] = pn[3]; \
        if ((t_) + 1 < nt) AT_STORES(KS, VS, ((t_) + 1) & 1, vsn); \
        __syncthreads(); \
        vsp = vs; vs = vsn; }
    if (2 < nt) AT_LOADS(kr, vr, 2);
    for (int t = 1; t < nt; t += 2) {
        AT_ITER(t, kr, vr, kr2, vr2);
        if (t + 1 < nt) { AT_ITER(t + 1, kr2, vr2, kr, vr); }
    }
#undef AT_LOADS
#undef AT_STORES
#undef AT_ITER
    { const LAS unsigned char* vb = L + AT_VOFF + vsp * AT_VB + vlane; s16x4 va[8], vn[8];
      AT_LDV(va, 0); AT_LDV(vn, 1); AT_MMV(va, 0); AT_LDV(va, 2); AT_MMV(vn, 1); AT_LDV(vn, 3); AT_MMV(va, 2); AT_MMV(vn, 3); }
    __syncthreads();
#undef AT_LOAD
#undef AT_STORE
#undef AT_QK
#undef AT_LDV
#undef AT_MMV
#undef AT_EXP
    u32x4 gwv[4];
    { const bf16_t* gp_ = PROJ + (rowbase + q0 + (tid >> 2)) * DIN + C_DG + h * 128 + 32 * (tid & 3);
#pragma unroll
      for (int j = 0; j < 4; ++j) gwv[j] = *(const u32x4*)(gp_ + 8 * j); }
    l_run = xhalf_sum(l_run);
    const float sc = (c == 0 ? 1.f : -lam) / l_run;
#pragma unroll
    for (int e = 0; e < 4; ++e)
#pragma unroll
        for (int r = 0; r < 16; ++r) o[e][r] *= sc;
    LAS float* X = (LAS float*)(L + AT_XOFF); LAS float* E = (LAS float*)(L + AT_EOFF);
    if (c == 1) {
#pragma unroll
        for (int e = 0; e < 4; ++e)
#pragma unroll
            for (int r = 0; r < 16; ++r) X[((e * 16 + r) * 4 + rb) * 64 + lane] = o[e][r];
    }
    __syncthreads();
    if (c == 0) {
#pragma unroll
        for (int e = 0; e < 4; ++e)
#pragma unroll
            for (int r = 0; r < 16; ++r) o[e][r] += X[((e * 16 + r) * 4 + rb) * 64 + lane];
#pragma unroll
        for (int e = 0; e < 4; ++e)
#pragma unroll
            for (int r4 = 0; r4 < 4; ++r4) *(LAS f32x4*)(E + (32 * rb + l31) * E_PITCH + 32 * e + 8 * r4 + 4 * hi) = (f32x4){o[e][4 * r4], o[e][4 * r4 + 1], o[e][4 * r4 + 2], o[e][4 * r4 + 3]};
    }
    __syncthreads();
    { const int row = tid >> 2, qtr = tid & 3; const LAS float* er = E + row * E_PITCH + 32 * qtr; f32x4 v[8]; float ss = 0.f;
#pragma unroll
      for (int j = 0; j < 8; ++j) { v[j] = *(const LAS f32x4*)(er + 4 * j); ss += (v[j][0] * v[j][0] + v[j][1] * v[j][1]) + (v[j][2] * v[j][2] + v[j][3] * v[j][3]); }
      ss += __shfl_xor(ss, 1); ss += __shfl_xor(ss, 2);
      const float rstd = one_m_li / sqrtf(ss * (1.f / 128.f) + EPS);
      const size_t m = rowbase + q0 + row; const bf16_t* gp = PROJ + m * DIN + C_DG + h * 128 + 32 * qtr; bf16_t* op = MIXED + m * 2048 + 768 + h * 128 + 32 * qtr; const float* sg = subln + 32 * qtr;
#pragma unroll
      for (int j = 0; j < 4; ++j) { const u32x4 gw = gwv[j]; const f32x4 a = v[2 * j], bq = v[2 * j + 1]; const f32x4 g0 = *(const f32x4*)(sg + 8 * j), g1 = *(const f32x4*)(sg + 8 * j + 4);
          u32x4 w; w.x = cvtpk(a[0] * rstd * g0[0] * silu(bflo(gw.x)), a[1] * rstd * g0[1] * silu(bfhi(gw.x))); w.y = cvtpk(a[2] * rstd * g0[2] * silu(bflo(gw.y)), a[3] * rstd * g0[3] * silu(bfhi(gw.y)));
          w.z = cvtpk(bq[0] * rstd * g1[0] * silu(bflo(gw.z)), bq[1] * rstd * g1[1] * silu(bfhi(gw.z))); w.w = cvtpk(bq[2] * rstd * g1[2] * silu(bflo(gw.w)), bq[3] * rstd * g1[3] * silu(bfhi(gw.w)));
          *(u32x4*)(op + 8 * j) = w; }
    }
    __syncthreads();
}

constexpr int RT_P = 320, RK_P = 272;
__device__ __forceinline__ void ret_kv_phase(LAS unsigned char* L, const bf16_t* PROJ, float* KV, int bid, int G) {
    int tid = threadIdx.x; asm volatile("" : "+v"(tid)); const int lane = tid & 63, wid = __builtin_amdgcn_readfirstlane(tid >> 6), l31 = lane & 31, hi = lane >> 5;
    LAS unsigned char* Kb = L; LAS unsigned char* Vb = L + 128 * RT_P;
    u32x4 rk[4], rv[4];
#define RK_LOAD(it_) { const int h_ = (it_) % 6, n_ = ((it_) / 6) % 64, b_ = (it_) / 384; const size_t rb_ = (size_t)b_ * SEQ + (size_t)n_ * 128; \
        _Pragma("unroll") for (int i_ = 0; i_ < 4; ++i_) { const int id = tid + 512 * i_, row = id >> 4, ch = id & 15; const bf16_t* src = PROJ + (rb_ + row) * DIN + h_ * 128 + ch * 8; \
            rk[i_] = *(const u32x4*)(src + C_RK); rv[i_] = *(const u32x4*)(src + C_RV); } }
    int it = bid;
    if (it < 768) RK_LOAD(it);
    for (; it < 768; it += G) {
        const int h = it % 6, n = (it / 6) % 64, b = it / 384;
        const float log2g = ret_log2g(h);
#pragma unroll
        for (int i = 0; i < 4; ++i) { const int id = tid + 512 * i, row = id >> 4, ch = id & 15;
            const u32x4 kv_ = rk[i];
            const float w = fexp2((float)(127 - row) * log2g);
            u32x4 ks; ks.x = cvtpk(bflo(kv_.x) * w, bfhi(kv_.x) * w); ks.y = cvtpk(bflo(kv_.y) * w, bfhi(kv_.y) * w); ks.z = cvtpk(bflo(kv_.z) * w, bfhi(kv_.z) * w); ks.w = cvtpk(bflo(kv_.w) * w, bfhi(kv_.w) * w);
            *(LAS u32x4*)(Kb + row * RT_P + ch * 16) = ks; *(LAS u32x4*)(Vb + row * RT_P + ch * 16) = rv[i]; }
        __syncthreads();
        if (it + G < 768) RK_LOAD(it + G);
        const int eb = wid >> 1, db0 = 2 * (wid & 1);
        const int g = lane >> 4, tq = (lane & 15) >> 2, tp = lane & 3;
        const int lanepart = (8 * hi + tq) * RT_P + (16 * (g & 1) + 4 * tp) * 2;
        f32x16 acc[2];
#pragma unroll
        for (int j = 0; j < 2; ++j)
#pragma unroll
            for (int r = 0; r < 16; ++r) acc[j][r] = 0.f;
#pragma unroll
        for (int s = 0; s < 8; ++s) {
            const LAS unsigned char* va = Vb + (16 * s) * RT_P + lanepart + 64 * eb;
            const bf16x8 A = cat8(tr_read(va), tr_read(va + 4 * RT_P));
#pragma unroll
            for (int j = 0; j < 2; ++j) { const LAS unsigned char* ka = Kb + (16 * s) * RT_P + lanepart + 64 * (db0 + j); const bf16x8 B = cat8(tr_read(ka), tr_read(ka + 4 * RT_P)); acc[j] = MFMA32(A, B, acc[j]); }
        }
        float* dst = KV + ((size_t)((b * 6 + h) * 64 + n)) * 16384;
#pragma unroll
        for (int j = 0; j < 2; ++j)
#pragma unroll
            for (int r = 0; r < 16; ++r) dst[(32 * eb + crow(r, hi)) * 128 + 32 * (db0 + j) + l31] = acc[j][r];
        __syncthreads();
    }
#undef RK_LOAD
}
__device__ __forceinline__ void ret_out_phase(LAS unsigned char* L, const bf16_t* PROJ, const bf16_t* SP, bf16_t* MIXED, int bid, int G) {
    int tid = threadIdx.x; asm volatile("" : "+v"(tid)); const int lane = tid & 63, wid = __builtin_amdgcn_readfirstlane(tid >> 6), l31 = lane & 31, hi = lane >> 5;
    LAS unsigned char* Kb = L; LAS unsigned char* Sb = L + 128 * RK_P; LAS unsigned char* Vb = L + 2 * 128 * RK_P; LAS unsigned char* Qb = Vb + 128 * RT_P;
    u32x4 rk[4], rv[4], rs_[4], rq[4];
#define RO_LOAD(it_) { const int h_ = (it_) % 6, n_ = ((it_) / 6) % 64, b_ = (it_) / 384; const size_t rb_ = (size_t)b_ * SEQ + (size_t)n_ * 128; \
        const bf16_t* sp_ = SP + ((size_t)((b_ * 6 + h_) * 64 + n_)) * 16384; \
        _Pragma("unroll") for (int i_ = 0; i_ < 4; ++i_) { const int id = tid + 512 * i_, row = id >> 4, ch = id & 15; const bf16_t* src = PROJ + (rb_ + row) * DIN + h_ * 128 + ch * 8; \
            rk[i_] = *(const u32x4*)(src + C_RK); rv[i_] = *(const u32x4*)(src + C_RV); rq[i_] = *(const u32x4*)(src + C_RQ); rs_[i_] = *(const u32x4*)(sp_ + row * 128 + ch * 8); } }
    int it = bid;
    if (it < 768) RO_LOAD(it);
    for (; it < 768; it += G) {
        const int h = it % 6, n = (it / 6) % 64, b = it / 384;
        const float log2g = ret_log2g(h);
        const size_t rowbase = (size_t)b * SEQ + (size_t)n * 128;
#pragma unroll
        for (int i = 0; i < 4; ++i) { const int id = tid + 512 * i, row = id >> 4, ch = id & 15;
            *(LAS u32x4*)(Kb + row * RK_P + ch * 16) = rk[i]; *(LAS u32x4*)(Vb + row * RT_P + ch * 16) = rv[i];
            *(LAS u32x4*)(Sb + row * RK_P + ch * 16) = rs_[i]; *(LAS u32x4*)(Qb + row * RK_P + ch * 16) = rq[i]; }
        __syncthreads();
        if (it + G < 768) RO_LOAD(it + G);
        u32x4 gwv[4];
        { const int row = tid >> 2, qtr = tid & 3; const bf16_t* gp = PROJ + (rowbase + row) * DIN + C_RG + h * 128 + 32 * qtr;
#pragma unroll
          for (int j = 0; j < 4; ++j) gwv[j] = *(const u32x4*)(gp + 8 * j); }
        const int ib = wid & 3, eh = wid >> 2;
        bf16x8 qf[8];
#pragma unroll
        for (int s = 0; s < 8; ++s) qf[s] = *(const LAS bf16x8*)(Qb + (32 * ib + l31) * RK_P + (16 * s + 8 * hi) * 2);
        f32x16 acc[2];
#pragma unroll
        for (int j = 0; j < 2; ++j)
#pragma unroll
            for (int r = 0; r < 16; ++r) acc[j][r] = 0.f;
#pragma unroll
        for (int s = 0; s < 8; ++s)
#pragma unroll
            for (int j = 0; j < 2; ++j) { const bf16x8 A = *(const LAS bf16x8*)(Sb + (32 * (2 * eh + j) + l31) * RK_P + (16 * s + 8 * hi) * 2); acc[j] = MFMA32(A, qf[s], acc[j]); }
        const int iloc = 32 * ib + l31;
        { const float qw = fexp2((float)(iloc + 1) * log2g);
#pragma unroll
          for (int j = 0; j < 2; ++j)
#pragma unroll
              for (int r = 0; r < 16; ++r) acc[j][r] *= qw; }
        const int g = lane >> 4, tq = (lane & 15) >> 2, tp = lane & 3;
        const int vlane = (4 * hi + tq) * RT_P + (16 * (g & 1) + 4 * tp) * 2;
        for (int jb = 0; jb <= ib; ++jb) {
            f32x16 S;
#pragma unroll
            for (int r = 0; r < 16; ++r) S[r] = 0.f;
#pragma unroll
            for (int s = 0; s < 8; ++s) { const bf16x8 A = *(const LAS bf16x8*)(Kb + (32 * jb + l31) * RK_P + (16 * s + 8 * hi) * 2); S = MFMA32(A, qf[s], S); }
#pragma unroll
            for (int r = 0; r < 16; ++r) { const int d = iloc - (32 * jb + crow(r, hi)); S[r] = d >= 0 ? S[r] * fexp2((float)d * log2g) : 0.f; }
            bf16x8 pb[2]; pb[0] = pack8(S, 0); pb[1] = pack8(S, 8);
#pragma unroll
            for (int t2 = 0; t2 < 2; ++t2)
#pragma unroll
                for (int j = 0; j < 2; ++j) { const LAS unsigned char* va = Vb + (32 * jb + 16 * t2) * RT_P + vlane + 64 * (2 * eh + j); acc[j] = MFMA32(cat8(tr_read(va), tr_read(va + 8 * RT_P)), pb[t2], acc[j]); }
        }
        __syncthreads();
        LAS float* E = (LAS float*)L;
#pragma unroll
        for (int j = 0; j < 2; ++j)
#pragma unroll
            for (int r4 = 0; r4 < 4; ++r4) *(LAS f32x4*)(E + (32 * ib + l31) * E_PITCH + 32 * (2 * eh + j) + 8 * r4 + 4 * hi) = (f32x4){acc[j][4 * r4], acc[j][4 * r4 + 1], acc[j][4 * r4 + 2], acc[j][4 * r4 + 3]};
        __syncthreads();
        { const int row = tid >> 2, qtr = tid & 3; const LAS float* er = E + row * E_PITCH + 32 * qtr; f32x4 v[8]; float ss = 0.f;
#pragma unroll
          for (int j = 0; j < 8; ++j) { v[j] = *(const LAS f32x4*)(er + 4 * j); ss += (v[j][0] * v[j][0] + v[j][1] * v[j][1]) + (v[j][2] * v[j][2] + v[j][3] * v[j][3]); }
          ss += __shfl_xor(ss, 1); ss += __shfl_xor(ss, 2);
          const float rstd = 1.f / sqrtf(ss * (1.f / 128.f) + EPS);
          bf16_t* op = MIXED + (rowbase + row) * 2048 + h * 128 + 32 * qtr;
#pragma unroll
          for (int j = 0; j < 4; ++j) { const u32x4 gw = gwv[j]; const f32x4 a = v[2 * j], bq = v[2 * j + 1];
              u32x4 w; w.x = cvtpk(a[0] * rstd * silu(bflo(gw.x)), a[1] * rstd * silu(bfhi(gw.x))); w.y = cvtpk(a[2] * rstd * silu(bflo(gw.y)), a[3] * rstd * silu(bfhi(gw.y)));
              w.z = cvtpk(bq[0] * rstd * silu(bflo(gw.z)), bq[1] * rstd * silu(bfhi(gw.z))); w.w = cvtpk(bq[2] * rstd * silu(bflo(gw.w)), bq[3] * rstd * silu(bfhi(gw.w)));
              *(u32x4*)(op + 8 * j) = w; }
        }
        __syncthreads();
    }
#undef RO_LOAD
}
constexpr int LR_XC = 0, LR_XCB = 49664, LR_GA = 76288, LR_LX = 76288, LR_XP = 97, LR_BP = 208;
constexpr int LR_CST = 125952;
__device__ __forceinline__ void lru_phase(LAS unsigned char* L, const Params& p, int layer, const bf16_t* PROJ, const bf16_t* LW, const float* C8, unsigned* HA, float* HEND, float* AEND, int bid, int G) {
    int tid = threadIdx.x; asm volatile("" : "+v"(tid)); const int lane = tid & 63, wid = __builtin_amdgcn_readfirstlane(tid >> 6), l31 = lane & 31, hi = lane >> 5;
    LAS float* XC = (LAS float*)(L + LR_XC); LAS unsigned char* XCB = L + LR_XCB; LAS float* GA = (LAS float*)(L + LR_GA); LAS unsigned char* LX = L + LR_LX; LAS float* CST = (LAS float*)(L + LR_CST);
    u32x4 lxr[4];
#define LRU_LOAD(it_) { const int jb_ = (it_) & 7, n_ = ((it_) >> 3) & 63, b_ = (it_) >> 9; const size_t rb_ = (size_t)b_ * SEQ + (size_t)n_ * 128; \
        _Pragma("unroll") for (int i_ = 0; i_ < 4; ++i_) { const int id = tid + 512 * i_; const int row = id / 12, ch = id - row * 12; lxr[i_] = (u32x4){0u, 0u, 0u, 0u}; \
            if (id < 131 * 12 && (n_ > 0 || row >= 3)) lxr[i_] = *(const u32x4*)(PROJ + (rb_ + row - 3) * DIN + C_LX + 96 * jb_ + 8 * ch); } }
    int it = bid;
    if (it < 1024) LRU_LOAD(it);
    for (; it < 1024; it += G) {
        const int jb = it & 7, n = (it >> 3) & 63, b = it >> 9;
        const size_t rowbase = (size_t)b * SEQ + (size_t)n * 128;
#pragma unroll
        for (int i = 0; i < 4; ++i) { const int id = tid + 512 * i; const int row = id / 12, ch = id - row * 12; if (id < 131 * 12) *(LAS u32x4*)(LX + row * 192 + ch * 16) = lxr[i]; }
        for (int e = tid; e < 768; e += 512) { const int a = e / 96, c = e - a * 96; float v;
            if (a == 0) v = p.ba[layer * 768 + 96 * jb + c]; else if (a == 1) v = p.bx[layer * 768 + 96 * jb + c]; else if (a == 2) v = C8[layer * 768 + 96 * jb + c];
            else if (a < 7) v = p.conv_w[(size_t)layer * 4 * 768 + (a - 3) * 768 + 96 * jb + c]; else v = p.conv_b[layer * 768 + 96 * jb + c];
            CST[e] = v; }
        const int tb = wid & 3, half = wid >> 2; const int cb0 = half == 0 ? 0 : 2, cb1 = half == 0 ? 2 : 3;
        const bf16_t* WA = LW + ((size_t)((layer * 2 + 0) * 8 + jb)) * 9216; const bf16_t* WX = LW + ((size_t)((layer * 2 + 1) * 8 + jb)) * 9216;
        bf16x8 fa[6], fx[6];
#pragma unroll
        for (int s = 0; s < 6; ++s) { fa[s] = *(const bf16x8*)(WA + (32 * cb0 + l31) * 96 + 16 * s + 8 * hi); fx[s] = *(const bf16x8*)(WX + (32 * cb0 + l31) * 96 + 16 * s + 8 * hi); }
        __syncthreads();
        if (it + G < 1024) LRU_LOAD(it + G);
        if (tid < 480) { const int c = tid % 96, grp = tid / 96; const int t0 = grp * 26, t1 = t0 + 26 < 128 ? t0 + 26 : 128;
            const float w0 = CST[3 * 96 + c], w1 = CST[4 * 96 + c], w2 = CST[5 * 96 + c], w3 = CST[6 * 96 + c], bs = CST[7 * 96 + c];
            const LAS unsigned short* lx = (const LAS unsigned short*)(LX + c * 2);
            float x0 = __uint_as_float((unsigned)lx[(t0 + 0) * 96] << 16), x1 = __uint_as_float((unsigned)lx[(t0 + 1) * 96] << 16), x2 = __uint_as_float((unsigned)lx[(t0 + 2) * 96] << 16);
            for (int t = t0; t < t1; ++t) { const float x3 = __uint_as_float((unsigned)lx[(t + 3) * 96] << 16);
                const float acc = bs + x0 * w0 + x1 * w1 + x2 * w2 + x3 * w3;
                XC[t * LR_XP + c] = acc; *(LAS unsigned short*)(XCB + t * LR_BP + c * 2) = (unsigned short)(cvtpk(acc, 0.f) & 0xffffu);
                x0 = x1; x1 = x2; x2 = x3; } }
        __syncthreads();
        { const int tok = 32 * tb + l31;
          for (int cbk = cb0; cbk < cb1; ++cbk) {
              f32x16 aR, aI;
#pragma unroll
              for (int r = 0; r < 16; ++r) { aR[r] = 0.f; aI[r] = 0.f; }
              if (cbk != cb0) {
#pragma unroll
                  for (int s = 0; s < 6; ++s) { fa[s] = *(const bf16x8*)(WA + (32 * cbk + l31) * 96 + 16 * s + 8 * hi); fx[s] = *(const bf16x8*)(WX + (32 * cbk + l31) * 96 + 16 * s + 8 * hi); }
              }
#pragma unroll
              for (int s = 0; s < 6; ++s) { const bf16x8 B = *(const LAS bf16x8*)(XCB + tok * LR_BP + (16 * s + 8 * hi) * 2); aR = MFMA32(fa[s], B, aR); aI = MFMA32(fx[s], B, aI); }
#pragma unroll
              for (int r = 0; r < 16; ++r) { const int cc = 32 * cbk + crow(r, hi);
                  const float rr = sigm(aR[r] + CST[cc]), ii = sigm(aI[r] + CST[96 + cc]);
                  const float log_a = rr * CST[192 + cc]; const float a = __expf(log_a); const float x2 = 2.f * log_a;
                  const float m1s = -x2 * (1.f + x2 * (0.5f + x2 * (0.16666667f + x2 * (0.041666668f + x2 * 0.008333334f))));
                  const float m1 = x2 < -0.25f ? 1.f - a * a : m1s;
                  const float mult = __builtin_amdgcn_sqrtf(m1);
                  const float xcv = XC[tok * LR_XP + cc];
                  GA[tok * LR_XP + cc] = a; XC[tok * LR_XP + cc] = mult * (ii * xcv); }
          }
        }
        __syncthreads();
        LAS float* SEGA = (LAS float*)XCB; LAS float* SEGH = SEGA + 4 * 96;
        const int sc_c = tid % 96, seg = tid / 96;
        float av[32], bv[32];
        if (tid < 384) {
#pragma unroll
            for (int t = 0; t < 32; ++t) { av[t] = GA[(32 * seg + t) * LR_XP + sc_c]; bv[t] = XC[(32 * seg + t) * LR_XP + sc_c]; }
            float A = 1.f, H = 0.f;
#pragma unroll
            for (int t = 0; t < 32; ++t) { H = av[t] * H + bv[t]; A *= av[t]; av[t] = A; bv[t] = H; }
            SEGA[seg * 96 + sc_c] = A; SEGH[seg * 96 + sc_c] = H; }
        __syncthreads();
        if (tid < 384) { float Hin = 0.f, Ain = 1.f;
            for (int s2 = 0; s2 < seg; ++s2) { Hin = SEGA[s2 * 96 + sc_c] * Hin + SEGH[s2 * 96 + sc_c]; Ain *= SEGA[s2 * 96 + sc_c]; }
            unsigned* dst = HA + (rowbase + 32 * seg) * 768 + 96 * jb + sc_c;
#pragma unroll
            for (int t = 0; t < 32; ++t) { const float Hf = bv[t] + av[t] * Hin, Af = av[t] * Ain; dst[(size_t)t * 768] = cvtpk(Hf, Af);
                if (t == 31 && seg == 3) { HEND[(size_t)(b * 64 + n) * 768 + 96 * jb + sc_c] = Hf; AEND[(size_t)(b * 64 + n) * 768 + 96 * jb + sc_c] = Af; } } }
        __syncthreads();
    }
#undef LRU_LOAD
}

#define XB_TMO      128
#define XB_XCNT(j)  (256  + 64 * (j))
#define XB_XSUB(j)  (1280 + 64 * (j))
#define XB_XGEN(j)  (2304 + 64 * (j))
#define XB_TOP      3328
#define XB_TOPGEN   3392
#define XCD_BAR_WORDS 3456
#define XB_SPIN_CAP (1u << 18)

__device__ __forceinline__ unsigned xb_ld(unsigned* p)              { return __hip_atomic_load(p, __ATOMIC_RELAXED, __HIP_MEMORY_SCOPE_AGENT); }
__device__ __forceinline__ unsigned xb_add(unsigned* p, unsigned v) { return __hip_atomic_fetch_add(p, v, __ATOMIC_RELAXED, __HIP_MEMORY_SCOPE_AGENT); }
__device__ __forceinline__ unsigned xb_xcc_id() { return (unsigned)__builtin_amdgcn_s_getreg((3 << 11) | 20) & 0xFu; }
#define XB_SPIN(cond, bar) do { unsigned _sp = 0; while (cond) { __builtin_amdgcn_s_sleep(1); \
    if ((++_sp & 255u) == 0u) { if (xb_ld(&(bar)[XB_TMO])) break; if (_sp > XB_SPIN_CAP) { atomicAdd(&(bar)[XB_TMO], 1u); break; } } } } while (0)

struct XcdBarrier {
    unsigned* bar; unsigned x;
    volatile LAS unsigned* st;
};

__device__ __forceinline__ XcdBarrier xcd_barrier_post(unsigned* bar, volatile LAS unsigned* st) {
    XcdBarrier b; b.bar = bar; b.x = xb_xcc_id(); b.st = st;
    if (threadIdx.x == 0) (void)xb_add(&bar[XB_XCNT(b.x)], 1u);
    return b;
}
__device__ __forceinline__ void xcd_barrier_complete(unsigned* bar, unsigned x, unsigned& nloc, unsigned& nx) {
    const unsigned G = gridDim.x * gridDim.y * gridDim.z;
    unsigned sum, cnt, mine, sp = 0u;
    for (;;) {
        sum = 0u; cnt = 0u; mine = 0u;
#pragma unroll
        for (unsigned j = 0; j < 16; ++j) { const unsigned c = xb_ld(&bar[XB_XCNT(j)]); sum += c; cnt += (c > 0u) ? 1u : 0u; mine = (j == x) ? c : mine; }
        if (sum == G) break;
        __builtin_amdgcn_s_sleep(1);
        if ((++sp & 255u) == 0u) { if (xb_ld(&bar[XB_TMO])) break; if (sp > XB_SPIN_CAP) { atomicAdd(&bar[XB_TMO], 1u); break; } }
    }
    nloc = mine > 0u ? mine : 1u; nx = cnt > 0u ? cnt : 1u;
}

__device__ __forceinline__ void xcd_barrier(const XcdBarrier& b) {
    asm volatile("s_waitcnt vmcnt(0)" ::: "memory");
    __syncthreads();
    if (threadIdx.x == 0) {
        unsigned* bar = b.bar;
        __builtin_amdgcn_s_waitcnt(0);
        unsigned nloc = b.st[0], nx = b.st[1];
        if (nloc == 0u) { xcd_barrier_complete(bar, b.x, nloc, nx); b.st[0] = nloc; b.st[1] = nx; }
        const unsigned old = xb_add(&bar[XB_XSUB(b.x)], 1u);
        const unsigned gen = old / nloc;
        if (old + 1u == (gen + 1u) * nloc) {
            __builtin_amdgcn_fence(__ATOMIC_RELEASE, "agent");
            asm volatile("s_waitcnt vmcnt(0)" ::: "memory");
            const unsigned og = xb_add(&bar[XB_TOP], 1u);
            const unsigned tg = og / nx;
            if (og + 1u == (tg + 1u) * nx) xb_add(&bar[XB_TOPGEN], 1u);
            else XB_SPIN(xb_ld(&bar[XB_TOPGEN]) == tg, bar);
            __builtin_amdgcn_fence(__ATOMIC_ACQUIRE, "agent");
            xb_add(&bar[XB_XGEN(b.x)], 1u);
            asm volatile("s_waitcnt vmcnt(0)" ::: "memory");
        } else {
            XB_SPIN(xb_ld(&bar[XB_XGEN(b.x)]) == gen, bar);
            __builtin_amdgcn_fence(__ATOMIC_ACQUIRE, "agent");
            asm volatile("s_waitcnt vmcnt(0)" ::: "memory");
        }
    }
    __syncthreads();
}

#ifndef REP_P0
#define REP_P0 1
#endif
#ifndef REP_G1
#define REP_G1 1
#endif
#ifndef REP_AT
#define REP_AT 1
#endif
#ifndef REP_RK
#define REP_RK 1
#endif
#ifndef REP_LR
#define REP_LR 1
#endif
#ifndef REP_SC
#define REP_SC 1
#endif
#ifndef REP_RO
#define REP_RO 1
#endif
#ifndef REP_G2
#define REP_G2 1
#endif
#ifndef REP_FN
#define REP_FN 1
#endif
__global__ void __launch_bounds__(512) mega_fwd(Params p) {
    extern __shared__ __attribute__((aligned(16))) unsigned char lds_raw[];
    LAS unsigned char* L = (LAS unsigned char*)lds_raw;
    cg::grid_group grid = cg::this_grid();
    unsigned char* ws = p.ws;
    const int G = gridDim.x, bid = blockIdx.x, NGW = G * 8, NT = G * 512;
#define TIDS int tid = threadIdx.x; asm volatile("" : "+v"(tid)); const int lane = tid & 63, wave = tid >> 6, gw = bid * 8 + wave, gt = bid * 512 + tid; (void)lane; (void)gw; (void)gt;
    bf16_t* XB = (bf16_t*)(ws + WS_XB); bf16_t* MIXED = (bf16_t*)p.out;     bf16_t* PROJ = (bf16_t*)(ws + WS_PROJ); bf16_t* Y = (bf16_t*)(ws + WS_Y);
    float* KV = (float*)(ws + WS_KV); bf16_t* SP = (bf16_t*)(ws + WS_SP); unsigned* HA = (unsigned*)(ws + WS_HL);
    float* HEND = (float*)(ws + WS_HEND); float* AEND = (float*)(ws + WS_AEND); float* CARRY = (float*)(ws + WS_CARRY);
    float* RSTD = (float*)(ws + WS_RSTD); const bf16_t* LW = (const bf16_t*)(ws + WS_LRUW);
    const int lo = p.ph_lo, hi = p.ph_hi;
    volatile LAS unsigned* bst = (volatile LAS unsigned*)(L + LDS_BARST);
    if (threadIdx.x < 8) bst[threadIdx.x] = 0u;
    __syncthreads();
    XcdBarrier xbar; xbar.bar = (unsigned*)(ws + WS_BAR); xbar.x = 0; xbar.st = bst;
    if (hi - lo > 1) xbar = xcd_barrier_post((unsigned*)(ws + WS_BAR), bst);
    unsigned* cen = (unsigned*)(ws + WS_BAR) + 3584;
    if (threadIdx.x == 0 && hi - lo > 1) { const unsigned xcc = xb_xcc_id(); bst[2] = xcc; bst[3] = xb_add(&cen[xcc], 1u); }
#define IN(k) (lo <= (k) && (k) < hi)
#define SEAM(k) do { if (IN(k) && IN((k) + 1)) { if (p.ph_hi > 1000) grid.sync(); else xcd_barrier(xbar); } } while (0)
    if (IN(0)) { for (int rep_ = 0; rep_ < REP_P0; ++rep_) phase0(p, L); }
    SEAM(0);
    int vid = bid;
    if (hi - lo > 1) {
        if (threadIdx.x == 0) { bool ok = (G % 8) == 0; for (int j = 0; j < 16; ++j) { const unsigned cj = xb_ld(&cen[j]); ok = ok && (cj == (j < 8 ? (unsigned)(G / 8) : 0u)); }
            bst[4] = ok ? (bst[2] + 8u * bst[3]) : (unsigned)bid; }
        __syncthreads();
        vid = (int)bst[4];
    }
    vid = __builtin_amdgcn_readfirstlane(vid);
#pragma unroll 1
    for (int layer = 0; layer < 2; ++layer) {
        const int kb_ = 1 + 6 * layer;
        float* SSQ = (float*)(ws + WS_SSQ) + layer * M;
        if (IN(kb_ + 0)) for (int rep_ = 0; rep_ < REP_G1; ++rep_) {
            pg8::Gemm g{XB, (const bf16_t*)(ws + WS_WIN) + (size_t)layer * DIN * 2048, M, DIN, 2048}; pg8::StaticOrder S; S.init(M, DIN, G, vid);
            pg8::EpiProj E{PROJ, RSTD, (const float*)(ws + WS_COSR), (const float*)(ws + WS_SINR), (const float*)(ws + WS_COSD), (const float*)(ws + WS_SIND)};
            pg8::gemm_phase<pg8::EpiProj, pg8::StaticOrder, true, true>(L, g, S, E);
        }
        SEAM(kb_ + 0);
        if (IN(kb_ + 1)) {
            float d1 = 0.f, d2 = 0.f;
            for (int i = 0; i < 64; ++i) { d1 += p.lq1[layer * 64 + i] * p.lk1[layer * 64 + i]; d2 += p.lq2[layer * 64 + i] * p.lk2[layer * 64 + i]; }
            const float lam_init = 0.8f - 0.6f * expf(-0.3f * (float)layer);
            const float lam = expf(d1) - expf(d2) + lam_init;
            for (int rep_ = 0; rep_ < REP_AT; ++rep_) for (int pi = vid; pi < 256; pi += G) { const int bh = pi & 7, pp = pi >> 3;
                attn_item(L, PROJ, MIXED, p.subln_g + layer * 128, bh >> 2, bh & 3, 63 - pp, lam, 1.f - lam_init);
                attn_item(L, PROJ, MIXED, p.subln_g + layer * 128, bh >> 2, bh & 3, pp, lam, 1.f - lam_init); }
            ret_kv_phase(L, PROJ, KV, bid, G);
            for (int rep_ = 0; rep_ < REP_LR; ++rep_) lru_phase(L, p, layer, PROJ, LW, (const float*)(ws + WS_C8), HA, HEND, AEND, bid, G);
        }
        SEAM(kb_ + 1);
        if (IN(kb_ + 2)) for (int rep_ = 0; rep_ < REP_SC; ++rep_) {
            TIDS
            typedef float f32x2 __attribute__((ext_vector_type(2)));
            for (int idx = gt; idx < 12 * 8192; idx += NT) { const int bh = idx >> 13, ed = (idx & 8191) * 2; const float cd = fexp2(128.f * ret_log2g(bh % 6));
                const float* src = KV + (size_t)bh * 64 * 16384 + ed; bf16_t* dst = SP + (size_t)bh * 64 * 16384 + ed; float st0 = 0.f, st1 = 0.f;
                for (int n0 = 0; n0 < 64; n0 += 8) { f32x2 v[8];
#pragma unroll
                    for (int i = 0; i < 8; ++i) v[i] = *(const f32x2*)(src + (size_t)(n0 + i) * 16384);
#pragma unroll
                    for (int i = 0; i < 8; ++i) { *(unsigned*)(dst + (size_t)(n0 + i) * 16384) = cvtpk(st0, st1); st0 = st0 * cd + v[i][0]; st1 = st1 * cd + v[i][1]; } } }
            for (int idx = gt; idx < 2 * 768; idx += NT) { const int b = idx / 768, c = idx - b * 768; float H = 0.f;
                for (int n0 = 0; n0 < 64; n0 += 8) { float a[8], hh[8];
#pragma unroll
                    for (int i = 0; i < 8; ++i) { a[i] = AEND[(size_t)(b * 64 + n0 + i) * 768 + c]; hh[i] = HEND[(size_t)(b * 64 + n0 + i) * 768 + c]; }
#pragma unroll
                    for (int i = 0; i < 8; ++i) { CARRY[(size_t)(b * 64 + n0 + i) * 768 + c] = H; H = a[i] * H + hh[i]; } } }
        }
        SEAM(kb_ + 2);
        if (IN(kb_ + 3)) for (int rep_ = 0; rep_ < REP_RO; ++rep_) {
            TIDS
            ret_out_phase(L, PROJ, SP, MIXED, bid, G);
            for (int idx = gt; idx < M * 96; idx += NT) { const int m = idx / 96, c = (idx - m * 96) * 8; const int bn = m >> 7;
                const u32x4 h0 = *(const u32x4*)(HA + (size_t)m * 768 + c), h1 = *(const u32x4*)(HA + (size_t)m * 768 + c + 4), lg = *(const u32x4*)(PROJ + (size_t)m * DIN + C_LG + c);
                const f32x4 c0 = *(const f32x4*)(CARRY + (size_t)bn * 768 + c), c1 = *(const f32x4*)(CARRY + (size_t)bn * 768 + c + 4);
                u32x4 w;
                w.x = cvtpk((bflo(h0.x) + bfhi(h0.x) * c0[0]) * silu(bflo(lg.x)), (bflo(h0.y) + bfhi(h0.y) * c0[1]) * silu(bfhi(lg.x)));
                w.y = cvtpk((bflo(h0.z) + bfhi(h0.z) * c0[2]) * silu(bflo(lg.y)), (bflo(h0.w) + bfhi(h0.w) * c0[3]) * silu(bfhi(lg.y)));
                w.z = cvtpk((bflo(h1.x) + bfhi(h1.x) * c1[0]) * silu(bflo(lg.z)), (bflo(h1.y) + bfhi(h1.y) * c1[1]) * silu(bfhi(lg.z)));
                w.w = cvtpk((bflo(h1.z) + bfhi(h1.z) * c1[2]) * silu(bflo(lg.w)), (bflo(h1.w) + bfhi(h1.w) * c1[3]) * silu(bfhi(lg.w)));
                *(u32x4*)(MIXED + (size_t)m * 2048 + 1280 + c) = w; }
        }
        SEAM(kb_ + 3);
        if (IN(kb_ + 4)) for (int rep_ = 0; rep_ < REP_G2; ++rep_) {
            pg8::Gemm g{MIXED, (const bf16_t*)(ws + WS_WOUT) + (size_t)layer * 2048 * 2048, M, 2048, 2048}; pg8::StaticOrder S; S.init(M, 2048, G, vid);
            pg8::EpiY E{Y, rep_ == 0 ? SSQ : (float*)(ws + WS_KV)};
            pg8::gemm_phase<pg8::EpiY, pg8::StaticOrder, true, true>(L, g, S, E);
        }
        SEAM(kb_ + 4);
        if (IN(kb_ + 5)) for (int rep_ = 0; rep_ < REP_FN; ++rep_) {
            TIDS
            const float* pg = p.post_g + layer * 2048;
            for (int m = gw; m < M; m += NGW) {
                const float rs = 1.f / sqrtf(SSQ[m] * (1.f / 2048.f) + EPS); float s = 0.f; f32x4 xn[8];
#pragma unroll
                for (int j = 0; j < 4; ++j) { const int col = j * 512 + lane * 8; const u32x4 yw = *(const u32x4*)(Y + (size_t)m * 2048 + col);
                    f32x4 x0, x1;
                    { const u32x4 xw = *(const u32x4*)(XB + (size_t)m * 2048 + col); x0 = (f32x4){bflo(xw.x), bfhi(xw.x), bflo(xw.y), bfhi(xw.y)}; x1 = (f32x4){bflo(xw.z), bfhi(xw.z), bflo(xw.w), bfhi(xw.w)}; }
                    const f32x4 g0 = *(const f32x4*)(pg + col), g1 = *(const f32x4*)(pg + col + 4);
                    f32x4 a, bq; a[0] = x0[0] + bflo(yw.x) * rs * g0[0]; a[1] = x0[1] + bfhi(yw.x) * rs * g0[1]; a[2] = x0[2] + bflo(yw.y) * rs * g0[2]; a[3] = x0[3] + bfhi(yw.y) * rs * g0[3];
                    bq[0] = x1[0] + bflo(yw.z) * rs * g1[0]; bq[1] = x1[1] + bfhi(yw.z) * rs * g1[1]; bq[2] = x1[2] + bflo(yw.w) * rs * g1[2]; bq[3] = x1[3] + bfhi(yw.w) * rs * g1[3];
                    xn[2 * j] = a; xn[2 * j + 1] = bq; s += (a[0] * a[0] + a[1] * a[1]) + (a[2] * a[2] + a[3] * a[3]) + (bq[0] * bq[0] + bq[1] * bq[1]) + (bq[2] * bq[2] + bq[3] * bq[3]);
                    if (layer != 0) { *(f32x4*)(p.out + (size_t)m * 2048 + col) = a; *(f32x4*)(p.out + (size_t)m * 2048 + col + 4) = bq; } }
                if (layer == 0) { s = wave_sum(s); if (lane == 0) RSTD[m] = 1.f / sqrtf(s * (1.f / 2048.f) + EPS);
#pragma unroll
                    for (int j = 0; j < 4; ++j) { const f32x4 a = xn[2 * j], bq = xn[2 * j + 1]; u32x4 w; w.x = cvtpk(a[0], a[1]); w.y = cvtpk(a[2], a[3]); w.z = cvtpk(bq[0], bq[1]); w.w = cvtpk(bq[2], bq[3]);
                        *(u32x4*)(XB + (size_t)m * 2048 + j * 512 + lane * 8) = w; } }
            }
        }
        SEAM(kb_ + 5);
    }
#undef IN
#undef SEAM
}

#ifndef MK_MULTI
#define MK_MULTI 0
#endif
constexpr int N_PHASES = 13;
extern "C" void kernel_launch(void* const* d_in, const int* in_sizes, int n_in, void* d_out, int out_size, void* d_ws, size_t ws_size, hipStream_t stream) {
    static int grid = 0;
    if (grid == 0) {
        if (n_in != 18 || ws_size < WS_END) { fprintf(stderr, "kernel_launch: unexpected inputs (n_in %d, ws %zu)\n", n_in, ws_size); grid = -1; return; }
        int dev = 0, cus = 0, per_cu = 0;
        hipGetDevice(&dev); hipDeviceGetAttribute(&cus, hipDeviceAttributeMultiprocessorCount, dev);
        hipFuncSetAttribute((const void*)mega_fwd, hipFuncAttributeMaxDynamicSharedMemorySize, LDS_BYTES);
        if (hipOccupancyMaxActiveBlocksPerMultiprocessor(&per_cu, (const void*)mega_fwd, 512, LDS_BYTES) != hipSuccess || per_cu < 1) per_cu = 1;
        (void)hipGetLastError();
        grid = cus * per_cu;
    }
    if (grid < 0) return;
    Params p{};
    p.x = (const float*)d_in[0]; p.pos = (const int*)d_in[1]; p.pre_g = (const float*)d_in[2]; p.w_in = (const float*)d_in[3];
    p.lq1 = (const float*)d_in[4]; p.lk1 = (const float*)d_in[5]; p.lq2 = (const float*)d_in[6]; p.lk2 = (const float*)d_in[7];
    p.subln_g = (const float*)d_in[8]; p.conv_w = (const float*)d_in[9]; p.conv_b = (const float*)d_in[10]; p.wa = (const float*)d_in[11]; p.ba = (const float*)d_in[12];
    p.wx = (const float*)d_in[13]; p.bx = (const float*)d_in[14]; p.lru_lam = (const float*)d_in[15]; p.w_out = (const float*)d_in[16]; p.post_g = (const float*)d_in[17];
    p.out = (float*)d_out; p.ws = (unsigned char*)d_ws;
#if MK_MULTI
    for (int ph = 0; ph < N_PHASES; ++ph) { p.ph_lo = ph; p.ph_hi = ph + 1; hipLaunchKernelGGL(mega_fwd, dim3(grid), dim3(512), LDS_BYTES, stream, p); }
#else
    p.ph_lo = 0; p.ph_hi = N_PHASES;
    if (hipMemsetAsync((char*)d_ws + WS_BAR, 0, WS_BAR_BYTES, stream) != hipSuccess) { fprintf(stderr, "kernel_launch: memset of barrier words failed\n"); return; }
    void* args[] = {&p};
    hipError_t e = hipLaunchCooperativeKernel((const void*)mega_fwd, dim3(grid), dim3(512), args, LDS_BYTES, stream);
    if (e != hipSuccess) fprintf(stderr, "cooperative launch failed: %s (grid %d)\n", hipGetErrorString(e), grid);
#endif
}
```

```cpp
#include <hip/hip_runtime.h>
#include <hip/hip_cooperative_groups.h>
#include <cstdio>
#include <cstdint>
namespace cg = cooperative_groups;
namespace pg8 {
#define PG8_LAS __attribute__((address_space(3)))
typedef unsigned short bf16_t;
typedef short bf16x8 __attribute__((ext_vector_type(8)));
typedef float f32x4 __attribute__((ext_vector_type(4)));
typedef unsigned u32x4 __attribute__((ext_vector_type(4)));
constexpr int BM = 256, BK = 64, HALF = 128, HTB = HALF * BK * 2  , STAGE_BYTES = 8 * HTB, NXCD = 8, WGM = 4;

__host__ __device__ __forceinline__ int lds_byte(int r, int c) { const int st = (r >> 4) * 2 + (c >> 5), rr = r & 15, cc = c & 31, ob = rr * 64 + cc * 2; return st * 1024 + (ob ^ (((ob >> 9) & 1) << 5)); }
__host__ __device__ __forceinline__ void stage_rc(int b, int& R, int& C) { const int st = b / 1024, sb = b % 1024, swz = sb ^ (((sb >> 9) & 1) << 5); R = (st >> 1) * 16 + swz / 64; C = (st & 1) * 32 + (swz % 64) / 2; }
__host__ __device__ __forceinline__ int perm32(int rho) { const int n = rho >> 4, i = rho & 15; return 8 * (i >> 2) + 4 * n + (i & 3); }

struct Unit { int pm, pn; };
struct Gemm { const bf16_t* A; const bf16_t* Bt; int M, N, K; };

struct StaticOrder {
    int nM, nN, nwg, G, c;
    __host__ __device__ void init(int M, int N, int G_, int c_) { nM = M / BM; nN = N / BM; nwg = nM * nN; G = G_; c = c_; }
    __host__ __device__ bool next(int i, Unit& u) const {
        const long L = (long)i * G + c; if (L >= nwg) return false;
        int wgid = (int)L; { const int q = nwg / NXCD, r = nwg % NXCD, xcd = wgid % NXCD, off = wgid / NXCD; wgid = (xcd < r ? xcd * (q + 1) : r * (q + 1) + (xcd - r) * q) + off; }
        const int nig = WGM * nN, gid = wgid / nig, fm = gid * WGM, gsz = (nM - fm) < WGM ? (nM - fm) : WGM;
        u.pm = fm + ((wgid % nig) % gsz); u.pn = (wgid % nig) / gsz; return true;
    }
    __device__ __forceinline__ void a_ready(const Unit&) const {}
    __device__ __forceinline__ void done(const Unit&) const {}
};
__device__ __forceinline__ unsigned cvt_pk_bf16(float lo, float hi) { unsigned r; asm volatile("v_cvt_pk_bf16_f32 %0, %1, %2" : "=v"(r) : "v"(lo), "v"(hi)); return r; }
typedef float f32x2 __attribute__((ext_vector_type(2)));
typedef unsigned u32x4 __attribute__((ext_vector_type(4)));
struct EpiProj {
    static constexpr bool PERM = true, AFTER_DRAIN = false;
    bf16_t* O; const float* rstd; const float* cosR; const float* sinR; const float* cosD; const float* sinD;
    __device__ __forceinline__ void operator()(const f32x4 (&acc)[2][2][4][2], const Unit& u, int wr, int wc, int fr, int fq) const {
        const int row0 = u.pm * BM + wr * 64 + fr; const int colt = u.pn * BM;
        int mode = 0; float sc = 1.f;
        if (colt < 768) { mode = 1; } else if (colt < 1536) { mode = 1; sc = 0.08838834764831845f; }
        else if (colt >= 3072 && colt < 3584) { mode = 2; sc = 0.125f * 1.4426950408889634f; } else if (colt >= 3584 && colt < 4096) { mode = 2; }
        const int colw = colt + wc * 32 + 8 * fq;
#pragma unroll
        for (int ai = 0; ai < 2; ++ai)
#pragma unroll
            for (int m = 0; m < 4; ++m) { const int row = row0 + ai * HALF + m * 16; const float rs = rstd[row] * sc;
#pragma unroll
                for (int bj = 0; bj < 2; ++bj) { const int col0 = colw + bj * HALF; f32x4 v0 = acc[ai][bj][m][0] * rs, v1 = acc[ai][bj][m][1] * rs;
                    if (mode != 0) {
                        f32x4 cs, sn;
                        if (mode == 1) { const int i0 = (col0 & 127) >> 1; cs = *(const f32x4*)(cosR + (size_t)row * 64 + i0); sn = *(const f32x4*)(sinR + (size_t)row * 64 + i0); }
                        else { const int i0 = (col0 & 63) >> 1; cs = *(const f32x4*)(cosD + (size_t)row * 32 + i0); sn = *(const f32x4*)(sinD + (size_t)row * 32 + i0); }
                        f32x4 w0, w1;
                        w0[0] = v0[0] * cs[0] - v0[1] * sn[0]; w0[1] = v0[1] * cs[0] + v0[0] * sn[0];
                        w0[2] = v0[2] * cs[1] - v0[3] * sn[1]; w0[3] = v0[3] * cs[1] + v0[2] * sn[1];
                        w1[0] = v1[0] * cs[2] - v1[1] * sn[2]; w1[1] = v1[1] * cs[2] + v1[0] * sn[2];
                        w1[2] = v1[2] * cs[3] - v1[3] * sn[3]; w1[3] = v1[3] * cs[3] + v1[2] * sn[3];
                        v0 = w0; v1 = w1;
                    }
                    u32x4 w; w.x = cvt_pk_bf16(v0[0], v0[1]); w.y = cvt_pk_bf16(v0[2], v0[3]); w.z = cvt_pk_bf16(v1[0], v1[1]); w.w = cvt_pk_bf16(v1[2], v1[3]);
                    *(u32x4*)(O + (size_t)row * 6656 + col0) = w; } }
    }
};
struct EpiY {
    static constexpr bool PERM = true, AFTER_DRAIN = false;
    bf16_t* Y; float* ssq;
    __device__ __forceinline__ void operator()(const f32x4 (&acc)[2][2][4][2], const Unit& u, int wr, int wc, int fr, int fq) const {
        const int row0 = u.pm * BM + wr * 64 + fr; const int colw = u.pn * BM + wc * 32 + 8 * fq;
#pragma unroll
        for (int ai = 0; ai < 2; ++ai)
#pragma unroll
            for (int m = 0; m < 4; ++m) { const int row = row0 + ai * HALF + m * 16; float s = 0.f;
#pragma unroll
                for (int bj = 0; bj < 2; ++bj) { const f32x4 v0 = acc[ai][bj][m][0], v1 = acc[ai][bj][m][1];
                    s += (v0[0] * v0[0] + v0[1] * v0[1]) + (v0[2] * v0[2] + v0[3] * v0[3]) + (v1[0] * v1[0] + v1[1] * v1[1]) + (v1[2] * v1[2] + v1[3] * v1[3]);
                    u32x4 w; w.x = cvt_pk_bf16(v0[0], v0[1]); w.y = cvt_pk_bf16(v0[2], v0[3]); w.z = cvt_pk_bf16(v1[0], v1[1]); w.w = cvt_pk_bf16(v1[2], v1[3]);
                    *(u32x4*)(Y + (size_t)row * 2048 + colw + bj * HALF) = w; }
                s += __shfl_xor(s, 16); s += __shfl_xor(s, 32);
                if (fq == 0) unsafeAtomicAdd(ssq + row, s); }
    }
};
template <class Epi, class Sched, bool ALIGN_EPI = false, bool SP2 = false>
__device__ __forceinline__ void gemm_phase(PG8_LAS unsigned char* lds, const Gemm g, const Sched& S, const Epi& E) {
    int tid = threadIdx.x; asm volatile("" : "+v"(tid)); const int wid = __builtin_amdgcn_readfirstlane(tid >> 6), lane = tid & 63, wr = wid >> 2, wc = wid & 3, fr = lane & 15, fq = lane >> 4;
    const int K = g.K, nt = K / BK;
    unsigned voffA[2], voffB[2];
#pragma unroll
    for (int i = 0; i < 2; ++i) { int R, C; stage_rc(tid * 16 + i * 8192, R, C); const int Rb = Epi::PERM ? ((R & ~31) + perm32(R & 31)) : R;
        voffA[i] = (unsigned)(R * K + C) * 2u; voffB[i] = (unsigned)(Rb * K + C) * 2u; }
    const size_t kstep = (size_t)(BK * 2);
    const size_t hstep = (size_t)HALF * K * 2;
    const size_t tstep = 2 * hstep;
    const unsigned ldsw = (unsigned)wid * 1024u;
    const int aoff = lds_byte(wr * 64 + fr, fq * 8), boff = lds_byte(wc * 32 + fr, fq * 8);
#define PG8_SA(b, h) (((b) * 2 + (h)) * HTB)
#define PG8_SB(b, h) ((4 + (b) * 2 + (h)) * HTB)
#define PG8_STAGE(bufoff, gbase, voff) do { _Pragma("unroll") for (int _i = 0; _i < 2; ++_i) \
        __builtin_amdgcn_global_load_lds((const unsigned*)((const char*)(gbase) + (voff)[_i]), (PG8_LAS unsigned*)(lds + (bufoff) + ldsw + _i * 8192), 16, 0, 0); } while (0)
#define PG8_LDA(dst, b, h) do { _Pragma("unroll") for (int m = 0; m < 4; ++m) _Pragma("unroll") for (int k = 0; k < 2; ++k) dst[m][k] = *(const PG8_LAS bf16x8*)(lds + PG8_SA(b, h) + aoff + m * 2048 + k * 1024); } while (0)
#define PG8_LDB(dst, b, h) do { _Pragma("unroll") for (int n = 0; n < 2; ++n) _Pragma("unroll") for (int k = 0; k < 2; ++k) dst[n][k] = *(const PG8_LAS bf16x8*)(lds + PG8_SB(b, h) + boff + n * 2048 + k * 1024); } while (0)
#define PG8_MMA(ai, bj, At, Bt) do { __builtin_amdgcn_s_setprio(1); _Pragma("unroll") for (int m = 0; m < 4; ++m) _Pragma("unroll") for (int n = 0; n < 2; ++n) _Pragma("unroll") for (int k = 0; k < 2; ++k) \
        acc[ai][bj][m][n] = __builtin_amdgcn_mfma_f32_16x16x32_bf16(Bt[n][k], At[m][k], acc[ai][bj][m][n], 0, 0, 0); __builtin_amdgcn_s_setprio(0); } while (0)
#define PG8_WAIT_V(n) asm volatile("s_waitcnt vmcnt(" #n ")" ::: "memory")
#define PG8_WAIT_L(n) asm volatile("s_waitcnt lgkmcnt(" #n ")" ::: "memory")
#define PG8_BAR __builtin_amdgcn_s_barrier()
#define PG8_SCHED __builtin_amdgcn_sched_barrier(0)
    Unit cur, nxt; int ui = 0;
    if (!S.next(0, cur)) return;
    f32x4 acc[2][2][4][2];
#pragma unroll
    for (int a = 0; a < 2; ++a)
#pragma unroll
        for (int b = 0; b < 2; ++b)
#pragma unroll
            for (int m = 0; m < 4; ++m)
#pragma unroll
                for (int n = 0; n < 2; ++n) acc[a][b][m][n] = (f32x4){0.f, 0.f, 0.f, 0.f};
    bf16x8 At[4][2], B0[2][2], B1[2][2];
    const char* cA = (const char*)g.A + (size_t)cur.pm * tstep; const char* cB = (const char*)g.Bt + (size_t)cur.pn * tstep;
    S.a_ready(cur);
    if constexpr (SP2) {
        PG8_STAGE(PG8_SB(0, 0), cB, voffB); PG8_STAGE(PG8_SB(0, 1), cB + hstep, voffB); PG8_STAGE(PG8_SA(0, 0), cA, voffA); PG8_STAGE(PG8_SA(0, 1), cA + hstep, voffA);
        if (wr == 1) PG8_BAR;
        PG8_WAIT_V(2); PG8_BAR;
        PG8_STAGE(PG8_SB(1, 0), cB + kstep, voffB); PG8_STAGE(PG8_SA(1, 0), cA + kstep, voffA); PG8_STAGE(PG8_SB(1, 1), cB + hstep + kstep, voffB);
        PG8_WAIT_V(6); PG8_BAR;
    } else {
        PG8_STAGE(PG8_SB(0, 0), cB, voffB); PG8_STAGE(PG8_SA(0, 0), cA, voffA); PG8_STAGE(PG8_SB(0, 1), cB + hstep, voffB); PG8_STAGE(PG8_SA(0, 1), cA + hstep, voffA);
        if (wr == 1) PG8_BAR;
        PG8_WAIT_V(4); PG8_BAR;
        PG8_STAGE(PG8_SB(1, 0), cB + kstep, voffB); PG8_STAGE(PG8_SA(1, 0), cA + kstep, voffA); PG8_STAGE(PG8_SB(1, 1), cB + hstep + kstep, voffB);
        PG8_WAIT_V(6); PG8_BAR;
    }
    for (;;) {
        const bool has_next = S.next(ui + 1, nxt);
        const char* nA = has_next ? (const char*)g.A + (size_t)nxt.pm * tstep : cA; const char* nB = has_next ? (const char*)g.Bt + (size_t)nxt.pn * tstep : cB;
        for (int t = 0; t < nt; t += 2) {
            const bool last = (t == nt - 2);
            const char* a1 = cA + (size_t)(t + 1) * kstep;
            const char* a2 = last ? nA : cA + (size_t)(t + 2) * kstep; const char* b2 = last ? nB : cB + (size_t)(t + 2) * kstep;
            const char* a3 = a2 + kstep; const char* b3 = b2 + kstep;
            if (last && has_next) S.a_ready(nxt);
            if constexpr (SP2) {
            PG8_LDB(B0, 0, 0); PG8_LDB(B1, 0, 1); PG8_SCHED; PG8_LDA(At, 0, 0); PG8_STAGE(PG8_SA(1, 1), a1 + hstep, voffA);
            PG8_WAIT_V(8); PG8_WAIT_L(0); PG8_BAR; PG8_MMA(0, 0, At, B0); PG8_MMA(0, 1, At, B1); PG8_BAR; PG8_SCHED;
            PG8_LDA(At, 0, 1); PG8_STAGE(PG8_SB(0, 0), b2, voffB); PG8_STAGE(PG8_SB(0, 1), b2 + hstep, voffB); PG8_STAGE(PG8_SA(0, 0), a2, voffA);
            PG8_WAIT_V(8); PG8_WAIT_L(0); PG8_BAR; PG8_MMA(1, 0, At, B0); PG8_MMA(1, 1, At, B1); PG8_BAR; PG8_SCHED;
            PG8_LDB(B0, 1, 0); PG8_LDB(B1, 1, 1); PG8_SCHED; PG8_LDA(At, 1, 0); PG8_STAGE(PG8_SA(0, 1), a2 + hstep, voffA);
            PG8_WAIT_V(8); PG8_WAIT_L(0); PG8_BAR; PG8_MMA(0, 0, At, B0); PG8_MMA(0, 1, At, B1); PG8_BAR; PG8_SCHED;
            PG8_LDA(At, 1, 1); PG8_STAGE(PG8_SB(1, 0), b3, voffB); PG8_STAGE(PG8_SB(1, 1), b3 + hstep, voffB); PG8_STAGE(PG8_SA(1, 0), a3, voffA);
            PG8_WAIT_V(8); PG8_WAIT_L(0); PG8_BAR; PG8_MMA(1, 0, At, B0); PG8_MMA(1, 1, At, B1); PG8_BAR; PG8_SCHED;
            } else {
            PG8_LDB(B0, 0, 0); PG8_SCHED; PG8_LDA(At, 0, 0); PG8_STAGE(PG8_SA(1, 1), a1 + hstep, voffA);
            PG8_WAIT_L(8); PG8_BAR; PG8_WAIT_L(0); PG8_MMA(0, 0, At, B0); PG8_BAR; PG8_SCHED;
            PG8_LDB(B1, 0, 1); PG8_STAGE(PG8_SB(0, 0), b2, voffB);
            PG8_BAR; PG8_WAIT_L(0); PG8_MMA(0, 1, At, B1); PG8_BAR;
            PG8_LDA(At, 0, 1); PG8_STAGE(PG8_SA(0, 0), a2, voffA);
            PG8_BAR; PG8_WAIT_L(0); PG8_MMA(1, 0, At, B0); PG8_BAR; PG8_SCHED;
            PG8_STAGE(PG8_SB(0, 1), b2 + hstep, voffB);
            PG8_WAIT_V(6); PG8_BAR; PG8_MMA(1, 1, At, B1); PG8_BAR;
            PG8_LDB(B0, 1, 0); PG8_SCHED; PG8_LDA(At, 1, 0); PG8_STAGE(PG8_SA(0, 1), a2 + hstep, voffA);
            PG8_WAIT_L(8); PG8_BAR; PG8_WAIT_L(0); PG8_MMA(0, 0, At, B0); PG8_BAR; PG8_SCHED;
            PG8_LDB(B1, 1, 1); PG8_STAGE(PG8_SB(1, 0), b3, voffB);
            PG8_BAR; PG8_WAIT_L(0); PG8_MMA(0, 1, At, B1); PG8_BAR;
            PG8_LDA(At, 1, 1); PG8_STAGE(PG8_SA(1, 0), a3, voffA);
            PG8_BAR; PG8_WAIT_L(0); PG8_MMA(1, 0, At, B0); PG8_BAR; PG8_SCHED;
            PG8_STAGE(PG8_SB(1, 1), b3 + hstep, voffB);
            PG8_WAIT_V(6); PG8_BAR; PG8_MMA(1, 1, At, B1); PG8_BAR;
            }
        }
        if constexpr (ALIGN_EPI) { if (wr == 0) PG8_BAR; }
        if constexpr (!Epi::AFTER_DRAIN) { E(acc, cur, wr, wc, fr, fq); S.done(cur); }
        if (!has_next) break;
#pragma unroll
        for (int a = 0; a < 2; ++a)
#pragma unroll
            for (int b = 0; b < 2; ++b)
#pragma unroll
                for (int m = 0; m < 4; ++m)
#pragma unroll
                    for (int n = 0; n < 2; ++n) acc[a][b][m][n] = (f32x4){0.f, 0.f, 0.f, 0.f};
        cur = nxt; cA = nA; cB = nB; ++ui;
        if constexpr (ALIGN_EPI) { if (wr == 1) PG8_BAR; }
    }
    PG8_WAIT_V(0);
    if constexpr (!ALIGN_EPI) { if (wr == 0) PG8_BAR; }
    PG8_BAR;
    if constexpr (Epi::AFTER_DRAIN) { E.fused(acc, cur, wr, wc, fr, fq, lds, wid, lane); S.done(cur); }
#undef PG8_SA
#undef PG8_SB
#undef PG8_STAGE
#undef PG8_LDA
#undef PG8_LDB
#undef PG8_MMA
#undef PG8_WAIT_V
#undef PG8_WAIT_L
#undef PG8_BAR
#undef PG8_SCHED
}
}
#define LAS __attribute__((address_space(3)))
typedef unsigned short bf16_t;
typedef short bf16x8 __attribute__((ext_vector_type(8)));
typedef short s16x4 __attribute__((ext_vector_type(4)));
typedef float f32x4 __attribute__((ext_vector_type(4)));
typedef float f32x16 __attribute__((ext_vector_type(16)));
typedef unsigned u32x4 __attribute__((ext_vector_type(4)));
constexpr int BATCH = 2, SEQ = 8192, DM = 2048, M = BATCH * SEQ, DIN = 6656;
constexpr int C_RQ = 0, C_RK = 768, C_RV = 1536, C_RG = 2304, C_DQ = 3072, C_DK = 3584, C_DV = 4096, C_DG = 4608, C_LX = 5120, C_LG = 5888;
constexpr float EPS = 1e-6f;
constexpr size_t MiB = 1u << 20;
constexpr size_t WS_SSQ = 0, WS_RSTD = 128 * 1024, WS_BAR = 256 * 1024, WS_BAR_BYTES = 16384, WS_C8 = 320 * 1024;
constexpr size_t WS_COSR = 1 * MiB, WS_SINR = 5 * MiB, WS_COSD = 9 * MiB, WS_SIND = 11 * MiB, WS_LRUW = 13 * MiB;
constexpr size_t WS_HEND = 14 * MiB, WS_AEND = 14 * MiB + 512 * 1024, WS_CARRY = 15 * MiB;
constexpr size_t WS_WIN = 16 * MiB, WS_WOUT = 68 * MiB, WS_XB = 84 * MiB, WS_PROJ = 148 * MiB, WS_KV = 356 * MiB, WS_SP = 404 * MiB, WS_HL = 428 * MiB, WS_AC = 452 * MiB, WS_END = 476 * MiB;
constexpr size_t WS_MIXED = WS_XB, WS_Y = WS_PROJ;
constexpr int LDS_BYTES = 147456, LDS_BARST = 147200;

struct Params {
    const float* x; const int* pos; const float* pre_g; const float* w_in; const float* lq1; const float* lk1; const float* lq2; const float* lk2;
    const float* subln_g; const float* conv_w; const float* conv_b; const float* wa; const float* ba; const float* wx; const float* bx; const float* lru_lam;
    const float* w_out; const float* post_g; float* out; unsigned char* ws; int ph_lo, ph_hi;
};

#define MFMA32(a, b, c) __builtin_amdgcn_mfma_f32_32x32x16_bf16((a), (b), (c), 0, 0, 0)
__device__ __forceinline__ unsigned cvtpk(float lo, float hi) { return pg8::cvt_pk_bf16(lo, hi); }
__device__ __forceinline__ float bflo(unsigned w) { return __uint_as_float(w << 16); }
__device__ __forceinline__ float bfhi(unsigned w) { return __uint_as_float(w & 0xffff0000u); }
__device__ __forceinline__ int crow(int r, int hi) { return (r & 3) + 8 * (r >> 2) + 4 * hi; }
typedef short v4i16_t __attribute__((ext_vector_type(4)));
__device__ __forceinline__ s16x4 tr_read(const LAS unsigned char* p) { return __builtin_bit_cast(s16x4, __builtin_amdgcn_ds_read_tr16_b64_v4i16((LAS v4i16_t*)p)); }
__device__ __forceinline__ bf16x8 cat8(s16x4 lo, s16x4 hi) { return __builtin_shufflevector(lo, hi, 0, 1, 2, 3, 4, 5, 6, 7); }
__device__ __forceinline__ bf16x8 pack8(const f32x16& s, int b) { u32x4 w; w.x = cvtpk(s[b], s[b + 1]); w.y = cvtpk(s[b + 2], s[b + 3]); w.z = cvtpk(s[b + 4], s[b + 5]); w.w = cvtpk(s[b + 6], s[b + 7]); return __builtin_bit_cast(bf16x8, w); }
__device__ __forceinline__ float wave_sum(float v) {
#pragma unroll
    for (int o = 1; o < 64; o <<= 1) v += __shfl_xor(v, o);
    return v;
}
__device__ __forceinline__ float fexp2(float x) { return __builtin_amdgcn_exp2f(x); }
__device__ __forceinline__ float sigm(float x) { return 1.f / (1.f + __expf(-x)); }
__device__ __forceinline__ float silu(float x) { return x / (1.f + __expf(-x)); }
__device__ __forceinline__ float ret_log2g(int h) { return log2f(1.f - exp2f(-5.f - (float)h)); }

__device__ __forceinline__ int src_col_in(int n) {
    if (n < 1536) { const int cn = n & 127; return (n - cn) + (cn >> 1) + 64 * (cn & 1); }
    if (n >= 3072 && n < 4096) { const int cn = n & 63; return (n - cn) + (cn >> 1) + 32 * (cn & 1); }
    return n;
}
__device__ __forceinline__ void p0_transpose_item(const float* W, int K, int N, bf16_t* WT, const float* gk, bool perm, LAS float* scr, int item, int lane) {
    const int nblk = N / 32, kb = item / nblk, nb = item % nblk, k0 = 64 * kb, n0 = 32 * nb;
    const int krow = lane >> 3, part = lane & 7;
    int srcc = n0 + 4 * part, dst0 = 4 * part, dstep = 1;
    if (perm && (n0 < 1536 || (n0 >= 3072 && n0 < 4096))) {
        const int H = n0 < 1536 ? 128 : 64, cn0 = n0 & (H - 1), seg = part >> 2, j4 = part & 3;
        srcc = (n0 - cn0) + (cn0 >> 1) + 4 * j4 + seg * (H >> 1); dst0 = 8 * j4 + seg; dstep = 2;
    }
#pragma unroll
    for (int i = 0; i < 8; ++i) { const int kk = 8 * i + krow; f32x4 v = __builtin_nontemporal_load((const f32x4*)(W + (size_t)(k0 + kk) * N + srcc));     if (gk) v = v * gk[k0 + kk];
        LAS float* d = scr + kk * 33 + dst0; d[0] = v[0]; d[dstep] = v[1]; d[2 * dstep] = v[2]; d[3 * dstep] = v[3]; }
    asm volatile("s_waitcnt lgkmcnt(0)" ::: "memory");
    const int c = lane & 7;
#pragma unroll
    for (int j = 0; j < 4; ++j) { const int n = (lane >> 3) + 8 * j; const LAS float* s = scr + (8 * c) * 33 + n;
        u32x4 o; o.x = cvtpk(s[0 * 33], s[1 * 33]); o.y = cvtpk(s[2 * 33], s[3 * 33]); o.z = cvtpk(s[4 * 33], s[5 * 33]); o.w = cvtpk(s[6 * 33], s[7 * 33]);
        *(u32x4*)(WT + (size_t)(n0 + n) * K + k0 + 8 * c) = o; }
    asm volatile("s_waitcnt lgkmcnt(0)" ::: "memory");
}
__device__ __forceinline__ void sincos_d(double a, float& s, float& c) {
    const double kq = rint(a * 0.63661977236758134308);
    double r = fma(-kq, 1.57079632679489655800e+00, a); r = fma(-kq, 6.12323399573676603587e-17, r);
    const int q = (int)((long long)kq & 3);
    const double r2 = r * r;
    const double sp = r * (1.0 + r2 * (-1.0 / 6.0 + r2 * (1.0 / 120.0 + r2 * (-1.0 / 5040.0 + r2 * (1.0 / 362880.0 + r2 * (-1.0 / 39916800.0 + r2 * (1.0 / 6227020800.0)))))));
    const double cp = 1.0 + r2 * (-0.5 + r2 * (1.0 / 24.0 + r2 * (-1.0 / 720.0 + r2 * (1.0 / 40320.0 + r2 * (-1.0 / 3628800.0 + r2 * (1.0 / 479001600.0))))));
    const double ss = (q & 1) ? cp : sp, cc = (q & 1) ? sp : cp;
    s = (float)((q & 2) ? -ss : ss); c = (float)(((q + 1) & 2) ? -cc : cc);
}
__device__ __forceinline__ void phase0(const Params& p, LAS unsigned char* L) {
    int tid = threadIdx.x; asm volatile("" : "+v"(tid)); const int lane = tid & 63, wave = tid >> 6;
    const int gw = blockIdx.x * 8 + wave, NGW = gridDim.x * 8, gt = blockIdx.x * 512 + tid, NT = gridDim.x * 512;
    unsigned char* ws = p.ws;
    LAS float* scr = (LAS float*)(L + wave * 16384);
    constexpr int I_IN = 32 * 208, I_OUT = 32 * 64, I_L = I_IN + I_OUT;
    for (int it = gw; it < 2 * I_L; it += NGW) {
        const int layer = it / I_L, r = it - layer * I_L;
        if (r < I_IN) p0_transpose_item(p.w_in + (size_t)layer * 2048 * DIN, 2048, DIN, (bf16_t*)(ws + WS_WIN) + (size_t)layer * DIN * 2048, p.pre_g + layer * 2048, true, scr, r, lane);
        else p0_transpose_item(p.w_out + (size_t)layer * 2048 * 2048, 2048, 2048, (bf16_t*)(ws + WS_WOUT) + (size_t)layer * 2048 * 2048, nullptr, false, scr, r - I_IN, lane);
    }
    float* rstd = (float*)(ws + WS_RSTD); bf16_t* XB = (bf16_t*)(ws + WS_XB);
    for (int m = gw; m < M; m += NGW) {
        const float* xr = p.x + (size_t)m * DM; f32x4 v[8]; float s = 0.f;
#pragma unroll
        for (int j = 0; j < 4; ++j) { v[2 * j] = __builtin_nontemporal_load((const f32x4*)(xr + j * 512 + lane * 8)); v[2 * j + 1] = __builtin_nontemporal_load((const f32x4*)(xr + j * 512 + lane * 8 + 4));
            const f32x4 a = v[2 * j], b = v[2 * j + 1]; s += (a[0] * a[0] + a[1] * a[1]) + (a[2] * a[2] + a[3] * a[3]) + (b[0] * b[0] + b[1] * b[1]) + (b[2] * b[2] + b[3] * b[3]); }
        s = wave_sum(s);
        if (lane == 0) rstd[m] = 1.f / sqrtf(s * (1.f / DM) + EPS);
#pragma unroll
        for (int j = 0; j < 4; ++j) { const f32x4 a = v[2 * j], b = v[2 * j + 1]; u32x4 w; w.x = cvtpk(a[0], a[1]); w.y = cvtpk(a[2], a[3]); w.z = cvtpk(b[0], b[1]); w.w = cvtpk(b[2], b[3]);
            *(u32x4*)(XB + (size_t)m * DM + j * 512 + lane * 8) = w; }
    }
    float* cosR = (float*)(ws + WS_COSR); float* sinR = (float*)(ws + WS_SINR); float* cosD = (float*)(ws + WS_COSD); float* sinD = (float*)(ws + WS_SIND);
    for (int e = gt; e < M * 96; e += NT) {
        const int m = e / 96, f = e - m * 96; const double pos = (double)p.pos[m];
        float s, c;
        if (f < 64) { const double inv = exp(-((double)f / 63.0) * 9.210340371976184); sincos_d(pos * inv, s, c); cosR[(size_t)m * 64 + f] = c; sinR[(size_t)m * 64 + f] = s; }
        else { const int i = f - 64; const double inv = exp(-((double)(2 * i) / 64.0) * 9.210340371976184); sincos_d(pos * inv, s, c); cosD[(size_t)m * 32 + i] = c; sinD[(size_t)m * 32 + i] = s; }
    }
    float* ssq = (float*)(ws + WS_SSQ);
    for (int e = gt; e < 2 * M; e += NT) ssq[e] = 0.f;
    float* C8 = (float*)(ws + WS_C8);
    for (int e = gt; e < 2 * 768; e += NT) C8[e] = -8.f * log1pf(expf(-p.lru_lam[e]));
    bf16_t* LW = (bf16_t*)(ws + WS_LRUW);
    for (int e = gt; e < 2 * 2 * 8 * 96 * 96; e += NT) {
        const int k = e % 96, j = (e / 96) % 96, n = (e / 9216) % 8, gate = (e / 73728) % 2, l = e / 147456;
        const float v = (gate ? p.wx : p.wa)[(size_t)((l * 8 + n) * 96 + k) * 96 + j];
        LW[e] = (bf16_t)(cvtpk(v, 0.f) & 0xffffu);
    }
}
constexpr int AT_KP = 272, AT_VP = 320, AT_KB = 64 * AT_KP, AT_VB = 64 * AT_VP, AT_KOFF = 0, AT_VOFF = 2 * AT_KB, AT_XOFF = 0, AT_EOFF = 65536, E_PITCH = 132;
__device__ __forceinline__ float max3f(float a, float b, float c) { float r; asm("v_max3_f32 %0, %1, %2, %3" : "=v"(r) : "v"(a), "v"(b), "v"(c)); return r; }
__device__ __forceinline__ float max2f(float a, float b) { float r; asm("v_max_f32_e32 %0, %1, %2" : "=v"(r) : "v"(a), "v"(b)); return r; }
__device__ __forceinline__ float xhalf_max(float m) { auto rr = __builtin_amdgcn_permlane32_swap(__float_as_uint(m), __float_as_uint(m), false, false); return max2f(__uint_as_float(rr[0]), __uint_as_float(rr[1])); }
__device__ __forceinline__ float xhalf_sum(float m) { auto rr = __builtin_amdgcn_permlane32_swap(__float_as_uint(m), __float_as_uint(m), false, false); return __uint_as_float(rr[0]) + __uint_as_float(rr[1]); }
__device__ __forceinline__ void attn_item(LAS unsigned char* L, const bf16_t* PROJ, bf16_t* MIXED, const float* subln, int b, int h, int qb, float lam, float one_m_li) {
    int tid = threadIdx.x; asm volatile("" : "+v"(tid)); const int lane = tid & 63, wid = __builtin_amdgcn_readfirstlane(tid >> 6), l31 = lane & 31, hi = lane >> 5;
    const int c = wid >> 2, rb = wid & 3;
    const int q0 = qb * 128; const size_t rowbase = (size_t)b * SEQ;
    bf16x8 qf[4];
    { const bf16_t* qp = PROJ + (rowbase + q0 + 32 * rb + l31) * DIN + C_DQ + h * 128 + c * 64 + 8 * hi;
#pragma unroll
      for (int s = 0; s < 4; ++s) qf[s] = *(const bf16x8*)(qp + 16 * s); }
    f32x16 o[4];
#pragma unroll
    for (int e = 0; e < 4; ++e)
#pragma unroll
        for (int r = 0; r < 16; ++r) o[e][r] = 0.f;
    float m_run = 0.f, l_run = 0.f;
    const int nt = (q0 + 128) / 64;
    const bf16_t* kg = PROJ + (rowbase + (tid >> 4)) * DIN + C_DK + h * 128 + (tid & 15) * 8;
    const bf16_t* vg = kg + (C_DV - C_DK);
    const int st_k = (tid >> 4) * AT_KP + (tid & 15) * 16, st_v = (tid >> 4) * AT_VP + (tid & 15) * 16;
    u32x4 kr[2], vr[2];
#define AT_LOAD(t) { _Pragma("unroll") for (int i_ = 0; i_ < 2; ++i_) { const size_t go_ = (size_t)((t) * 64 + 32 * i_) * DIN; kr[i_] = *(const u32x4*)(kg + go_); vr[i_] = *(const u32x4*)(vg + go_); } }
#define AT_STORE(kbf, vsl) { _Pragma("unroll") for (int i_ = 0; i_ < 2; ++i_) { *(LAS u32x4*)(L + AT_KOFF + (kbf) * AT_KB + st_k + 32 * i_ * AT_KP) = kr[i_]; *(LAS u32x4*)(L + AT_VOFF + (vsl) * AT_VB + st_v + 32 * i_ * AT_VP) = vr[i_]; } }
    AT_LOAD(0); AT_STORE(0, 0); __syncthreads();
    const int g = lane >> 4, tq = (lane & 15) >> 2, tp = lane & 3;
    const int vlane = (4 * hi + tq) * AT_VP + (16 * (g & 1) + 4 * tp) * 2;
    const int klane = l31 * AT_KP + (c * 64 + 8 * hi) * 2;
    const int qi = q0 + 32 * rb + l31;
    bf16x8 pb[4];
    f32x16 s0, s1;
#define AT_QK(t_) { const int k0 = (t_) * 64; \
        const LAS unsigned char* kb = L + AT_KOFF + ((t_) & 1) * AT_KB + klane; bf16x8 ka[4], kc[4]; \
        _Pragma("unroll") for (int s = 0; s < 4; ++s) { ka[s] = *(const LAS bf16x8*)(kb + s * 32); kc[s] = *(const LAS bf16x8*)(kb + 32 * AT_KP + s * 32); } \
        _Pragma("unroll") for (int r = 0; r < 16; ++r) { s0[r] = 0.f; s1[r] = 0.f; } \
        _Pragma("unroll") for (int s = 0; s < 4; ++s) { s0 = MFMA32(ka[s], qf[s], s0); s1 = MFMA32(kc[s], qf[s], s1); } \
        if (k0 + 63 > q0 + 32 * rb) { _Pragma("unroll") for (int r = 0; r < 16; ++r) { const int key = k0 + crow(r, hi); if (key > qi) s0[r] = -INFINITY; if (key + 32 > qi) s1[r] = -INFINITY; } } \
        asm volatile("s_nop 15\n\ts_nop 7" : "+v"(s0), "+v"(s1));     \
        { float ma = max3f(s0[0], s0[1], s1[0]), mb = max3f(s0[2], s0[3], s1[1]); ma = max3f(ma, s1[2], s1[3]); \
          _Pragma("unroll") for (int r = 4; r < 16; r += 4) { ma = max3f(ma, s0[r], s0[r + 1]); mb = max3f(mb, s0[r + 2], s0[r + 3]); ma = max3f(ma, s1[r], s1[r + 1]); mb = max3f(mb, s1[r + 2], s1[r + 3]); } \
          mx = xhalf_max(max2f(ma, mb)); } }
#define AT_LDV(dst, ks_) { _Pragma("unroll") for (int e = 0; e < 4; ++e) { dst[2 * e] = tr_read(vb + (16 * (ks_)) * AT_VP + 64 * e); dst[2 * e + 1] = tr_read(vb + (16 * (ks_) + 8) * AT_VP + 64 * e); } }
#define AT_MMV(src, ks_) { _Pragma("unroll") for (int e = 0; e < 4; ++e) o[e] = MFMA32(cat8(src[2 * e], src[2 * e + 1]), pb[ks_], o[e]); }
#define AT_EXP(S, lo_) { _Pragma("unroll") for (int r = (lo_); r < (lo_) + 8; ++r) { S[r] = fexp2(S[r] - m_new); rs += S[r]; } }
    { float mx; AT_QK(0); m_run = mx; const float m_new = mx; float rs = 0.f; AT_EXP(s0, 0); AT_EXP(s0, 8); AT_EXP(s1, 0); AT_EXP(s1, 8); l_run = rs;
      pb[0] = pack8(s0, 0); pb[1] = pack8(s0, 8); pb[2] = pack8(s1, 0); pb[3] = pack8(s1, 8); }
    int vs = 1, vsp = 0;
    AT_LOAD(1); AT_STORE(1, 1); __syncthreads();
    u32x4 kr2[2], vr2[2];
#define AT_LOADS(KR, VR, t) { _Pragma("unroll") for (int i_ = 0; i_ < 2; ++i_) { const size_t go_ = (size_t)((t) * 64 + 32 * i_) * DIN; KR[i_] = *(const u32x4*)(kg + go_); VR[i_] = *(const u32x4*)(vg + go_); } }
#define AT_STORES(KR, VR, kbf, vsl) { _Pragma("unroll") for (int i_ = 0; i_ < 2; ++i_) { *(LAS u32x4*)(L + AT_KOFF + (kbf) * AT_KB + st_k + 32 * i_ * AT_KP) = KR[i_]; *(LAS u32x4*)(L + AT_VOFF + (vsl) * AT_VB + st_v + 32 * i_ * AT_VP) = VR[i_]; } }
#define AT_ITER(t_, KS, VS, KL, VL) { \
        const int vsn = vs == 2 ? 0 : vs + 1; \
        if ((t_) + 2 < nt) AT_LOADS(KL, VL, (t_) + 2); \
        const LAS unsigned char* vb = L + AT_VOFF + vsp * AT_VB + vlane; s16x4 va[8], vn[8]; \
        AT_LDV(va, 0); AT_LDV(vn, 1);     \
        float mx; AT_QK(t_); \
        const bool need = __any(mx > m_run); \
        const float m_new = max2f(m_run, mx); \
        float rs = 0.f; \
        AT_MMV(va, 0); AT_EXP(s0, 0); AT_LDV(va, 2); \
        AT_MMV(vn, 1); AT_EXP(s0, 8); AT_LDV(vn, 3); \
        AT_MMV(va, 2); AT_EXP(s1, 0); \
        AT_MMV(vn, 3); AT_EXP(s1, 8); \
        bf16x8 pn[4]; pn[0] = pack8(s0, 0); pn[1] = pack8(s0, 8); pn[2] = pack8(s1, 0); pn[3] = pack8(s1, 8); \
        asm volatile("" : "+v"(pn[0]), "+v"(pn[1]), "+v"(pn[2]), "+v"(pn[3]), "+v"(rs)); \
        if (need) { const float alpha = fexp2(m_run - m_new); l_run *= alpha; \
            _Pragma("unroll") for (int e = 0; e < 4; ++e) _Pragma("unroll") for (int r = 0; r < 16; ++r) o[e][r] *= alpha; } \
        m_run = m_new; l_run += rs; \
        pb[0] = pn[0]; pb[1] = pn[1]; pb[2] = pn[2]; pb[3] = pn[3]; \
        if ((t_) + 1 < nt) AT_STORES(KS, VS, ((t_) + 1) & 1, vsn); \
        __syncthreads(); \
        vsp = vs; vs = vsn; }
    if (2 < nt) AT_LOADS(kr, vr, 2);
    for (int t = 1; t < nt; t += 2) {
        AT_ITER(t, kr, vr, kr2, vr2);
        if (t + 1 < nt) { AT_ITER(t + 1, kr2, vr2, kr, vr); }
    }
#undef AT_LOADS
#undef AT_STORES
#undef AT_ITER
    { const LAS unsigned char* vb = L + AT_VOFF + vsp * AT_VB + vlane; s16x4 va[8], vn[8];
      AT_LDV(va, 0); AT_LDV(vn, 1); AT_MMV(va, 0); AT_LDV(va, 2); AT_MMV(vn, 1); AT_LDV(vn, 3); AT_MMV(va, 2); AT_MMV(vn, 3); }
    __syncthreads();
#undef AT_LOAD
#undef AT_STORE
#undef AT_QK
#undef AT_LDV
#undef AT_MMV
#undef AT_EXP
    u32x4 gwv[4];
    { const bf16_t* gp_ = PROJ + (rowbase + q0 + (tid >> 2)) * DIN + C_DG + h * 128 + 32 * (tid & 3);
#pragma unroll
      for (int j = 0; j < 4; ++j) gwv[j] = *(const u32x4*)(gp_ + 8 * j); }
    l_run = xhalf_sum(l_run);
    const float sc = (c == 0 ? 1.f : -lam) / l_run;
#pragma unroll
    for (int e = 0; e < 4; ++e)
#pragma unroll
        for (int r = 0; r < 16; ++r) o[e][r] *= sc;
    LAS float* X = (LAS float*)(L + AT_XOFF); LAS float* E = (LAS float*)(L + AT_EOFF);
    if (c == 1) {
#pragma unroll
        for (int e = 0; e < 4; ++e)
#pragma unroll
            for (int r = 0; r < 16; ++r) X[((e * 16 + r) * 4 + rb) * 64 + lane] = o[e][r];
    }
    __syncthreads();
    if (c == 0) {
#pragma unroll
        for (int e = 0; e < 4; ++e)
#pragma unroll
            for (int r = 0; r < 16; ++r) o[e][r] += X[((e * 16 + r) * 4 + rb) * 64 + lane];
#pragma unroll
        for (int e = 0; e < 4; ++e)
#pragma unroll
            for (int r4 = 0; r4 < 4; ++r4) *(LAS f32x4*)(E + (32 * rb + l31) * E_PITCH + 32 * e + 8 * r4 + 4 * hi) = (f32x4){o[e][4 * r4], o[e][4 * r4 + 1], o[e][4 * r4 + 2], o[e][4 * r4 + 3]};
    }
    __syncthreads();
    { const int row = tid >> 2, qtr = tid & 3; const LAS float* er = E + row * E_PITCH + 32 * qtr; f32x4 v[8]; float ss = 0.f;
#pragma unroll
      for (int j = 0; j < 8; ++j) { v[j] = *(const LAS f32x4*)(er + 4 * j); ss += (v[j][0] * v[j][0] + v[j][1] * v[j][1]) + (v[j][2] * v[j][2] + v[j][3] * v[j][3]); }
      ss += __shfl_xor(ss, 1); ss += __shfl_xor(ss, 2);
      const float rstd = one_m_li / sqrtf(ss * (1.f / 128.f) + EPS);
      const size_t m = rowbase + q0 + row; const bf16_t* gp = PROJ + m * DIN + C_DG + h * 128 + 32 * qtr; bf16_t* op = MIXED + m * 2048 + 768 + h * 128 + 32 * qtr; const float* sg = subln + 32 * qtr;
#pragma unroll
      for (int j = 0; j < 4; ++j) { const u32x4 gw = gwv[j]; const f32x4 a = v[2 * j], bq = v[2 * j + 1]; const f32x4 g0 = *(const f32x4*)(sg + 8 * j), g1 = *(const f32x4*)(sg + 8 * j + 4);
          u32x4 w; w.x = cvtpk(a[0] * rstd * g0[0] * silu(bflo(gw.x)), a[1] * rstd * g0[1] * silu(bfhi(gw.x))); w.y = cvtpk(a[2] * rstd * g0[2] * silu(bflo(gw.y)), a[3] * rstd * g0[3] * silu(bfhi(gw.y)));
          w.z = cvtpk(bq[0] * rstd * g1[0] * silu(bflo(gw.z)), bq[1] * rstd * g1[1] * silu(bfhi(gw.z))); w.w = cvtpk(bq[2] * rstd * g1[2] * silu(bflo(gw.w)), bq[3] * rstd * g1[3] * silu(bfhi(gw.w)));
          *(u32x4*)(op + 8 * j) = w; }
    }
    __syncthreads();
}

constexpr int RT_P = 320, RK_P = 272;
__device__ __forceinline__ void ret_kv_phase(LAS unsigned char* L, const bf16_t* PROJ, float* KV, int bid, int G) {
    int tid = threadIdx.x; asm volatile("" : "+v"(tid)); const int lane = tid & 63, wid = __builtin_amdgcn_readfirstlane(tid >> 6), l31 = lane & 31, hi = lane >> 5;
    LAS unsigned char* Kb = L; LAS unsigned char* Vb = L + 128 * RT_P;
    u32x4 rk[4], rv[4];
#define RK_LOAD(it_) { const int h_ = (it_) % 6, n_ = ((it_) / 6) % 64, b_ = (it_) / 384; const size_t rb_ = (size_t)b_ * SEQ + (size_t)n_ * 128; \
        _Pragma("unroll") for (int i_ = 0; i_ < 4; ++i_) { const int id = tid + 512 * i_, row = id >> 4, ch = id & 15; const bf16_t* src = PROJ + (rb_ + row) * DIN + h_ * 128 + ch * 8; \
            rk[i_] = *(const u32x4*)(src + C_RK); rv[i_] = *(const u32x4*)(src + C_RV); } }
    int it = bid;
    if (it < 768) RK_LOAD(it);
    for (; it < 768; it += G) {
        const int h = it % 6, n = (it / 6) % 64, b = it / 384;
        const float log2g = ret_log2g(h);
#pragma unroll
        for (int i = 0; i < 4; ++i) { const int id = tid + 512 * i, row = id >> 4, ch = id & 15;
            const u32x4 kv_ = rk[i];
            const float w = fexp2((float)(127 - row) * log2g);
            u32x4 ks; ks.x = cvtpk(bflo(kv_.x) * w, bfhi(kv_.x) * w); ks.y = cvtpk(bflo(kv_.y) * w, bfhi(kv_.y) * w); ks.z = cvtpk(bflo(kv_.z) * w, bfhi(kv_.z) * w); ks.w = cvtpk(bflo(kv_.w) * w, bfhi(kv_.w) * w);
            *(LAS u32x4*)(Kb + row * RT_P + ch * 16) = ks; *(LAS u32x4*)(Vb + row * RT_P + ch * 16) = rv[i]; }
        __syncthreads();
        if (it + G < 768) RK_LOAD(it + G);
        const int eb = wid >> 1, db0 = 2 * (wid & 1);
        const int g = lane >> 4, tq = (lane & 15) >> 2, tp = lane & 3;
        const int lanepart = (8 * hi + tq) * RT_P + (16 * (g & 1) + 4 * tp) * 2;
        f32x16 acc[2];
#pragma unroll
        for (int j = 0; j < 2; ++j)
#pragma unroll
            for (int r = 0; r < 16; ++r) acc[j][r] = 0.f;
#pragma unroll
        for (int s = 0; s < 8; ++s) {
            const LAS unsigned char* va = Vb + (16 * s) * RT_P + lanepart + 64 * eb;
            const bf16x8 A = cat8(tr_read(va), tr_read(va + 4 * RT_P));
#pragma unroll
            for (int j = 0; j < 2; ++j) { const LAS unsigned char* ka = Kb + (16 * s) * RT_P + lanepart + 64 * (db0 + j); const bf16x8 B = cat8(tr_read(ka), tr_read(ka + 4 * RT_P)); acc[j] = MFMA32(A, B, acc[j]); }
        }
        float* dst = KV + ((size_t)((b * 6 + h) * 64 + n)) * 16384;
#pragma unroll
        for (int j = 0; j < 2; ++j)
#pragma unroll
            for (int r = 0; r < 16; ++r) dst[(32 * eb + crow(r, hi)) * 128 + 32 * (db0 + j) + l31] = acc[j][r];
        __syncthreads();
    }
#undef RK_LOAD
}
__device__ __forceinline__ void ret_out_phase(LAS unsigned char* L, const bf16_t* PROJ, const bf16_t* SP, bf16_t* MIXED, int bid, int G) {
    int tid = threadIdx.x; asm volatile("" : "+v"(tid)); const int lane = tid & 63, wid = __builtin_amdgcn_readfirstlane(tid >> 6), l31 = lane & 31, hi = lane >> 5;
    LAS unsigned char* Kb = L; LAS unsigned char* Sb = L + 128 * RK_P; LAS unsigned char* Vb = L + 2 * 128 * RK_P; LAS unsigned char* Qb = Vb + 128 * RT_P;
    u32x4 rk[4], rv[4], rs_[4], rq[4];
#define RO_LOAD(it_) { const int h_ = (it_) % 6, n_ = ((it_) / 6) % 64, b_ = (it_) / 384; const size_t rb_ = (size_t)b_ * SEQ + (size_t)n_ * 128; \
        const bf16_t* sp_ = SP + ((size_t)((b_ * 6 + h_) * 64 + n_)) * 16384; \
        _Pragma("unroll") for (int i_ = 0; i_ < 4; ++i_) { const int id = tid + 512 * i_, row = id >> 4, ch = id & 15; const bf16_t* src = PROJ + (rb_ + row) * DIN + h_ * 128 + ch * 8; \
            rk[i_] = *(const u32x4*)(src + C_RK); rv[i_] = *(const u32x4*)(src + C_RV); rq[i_] = *(const u32x4*)(src + C_RQ); rs_[i_] = *(const u32x4*)(sp_ + row * 128 + ch * 8); } }
    int it = bid;
    if (it < 768) RO_LOAD(it);
    for (; it < 768; it += G) {
        const int h = it % 6, n = (it / 6) % 64, b = it / 384;
        const float log2g = ret_log2g(h);
        const size_t rowbase = (size_t)b * SEQ + (size_t)n * 128;
#pragma unroll
        for (int i = 0; i < 4; ++i) { const int id = tid + 512 * i, row = id >> 4, ch = id & 15;
            *(LAS u32x4*)(Kb + row * RK_P + ch * 16) = rk[i]; *(LAS u32x4*)(Vb + row * RT_P + ch * 16) = rv[i];
            *(LAS u32x4*)(Sb + row * RK_P + ch * 16) = rs_[i]; *(LAS u32x4*)(Qb + row * RK_P + ch * 16) = rq[i]; }
        __syncthreads();
        if (it + G < 768) RO_LOAD(it + G);
        u32x4 gwv[4];
        { const int row = tid >> 2, qtr = tid & 3; const bf16_t* gp = PROJ + (rowbase + row) * DIN + C_RG + h * 128 + 32 * qtr;
#pragma unroll
          for (int j = 0; j < 4; ++j) gwv[j] = *(const u32x4*)(gp + 8 * j); }
        const int ib = wid & 3, eh = wid >> 2;
        bf16x8 qf[8];
#pragma unroll
        for (int s = 0; s < 8; ++s) qf[s] = *(const LAS bf16x8*)(Qb + (32 * ib + l31) * RK_P + (16 * s + 8 * hi) * 2);
        f32x16 acc[2];
#pragma unroll
        for (int j = 0; j < 2; ++j)
#pragma unroll
            for (int r = 0; r < 16; ++r) acc[j][r] = 0.f;
#pragma unroll
        for (int s = 0; s < 8; ++s)
#pragma unroll
            for (int j = 0; j < 2; ++j) { const bf16x8 A = *(const LAS bf16x8*)(Sb + (32 * (2 * eh + j) + l31) * RK_P + (16 * s + 8 * hi) * 2); acc[j] = MFMA32(A, qf[s], acc[j]); }
        const int iloc = 32 * ib + l31;
        { const float qw = fexp2((float)(iloc + 1) * log2g);
#pragma unroll
          for (int j = 0; j < 2; ++j)
#pragma unroll
              for (int r = 0; r < 16; ++r) acc[j][r] *= qw; }
        const int g = lane >> 4, tq = (lane & 15) >> 2, tp = lane & 3;
        const int vlane = (4 * hi + tq) * RT_P + (16 * (g & 1) + 4 * tp) * 2;
        for (int jb = 0; jb <= ib; ++jb) {
            f32x16 S;
#pragma unroll
            for (int r = 0; r < 16; ++r) S[r] = 0.f;
#pragma unroll
            for (int s = 0; s < 8; ++s) { const bf16x8 A = *(const LAS bf16x8*)(Kb + (32 * jb + l31) * RK_P + (16 * s + 8 * hi) * 2); S = MFMA32(A, qf[s], S); }
#pragma unroll
            for (int r = 0; r < 16; ++r) { const int d = iloc - (32 * jb + crow(r, hi)); S[r] = d >= 0 ? S[r] * fexp2((float)d * log2g) : 0.f; }
            bf16x8 pb[2]; pb[0] = pack8(S, 0); pb[1] = pack8(S, 8);
#pragma unroll
            for (int t2 = 0; t2 < 2; ++t2)
#pragma unroll
                for (int j = 0; j < 2; ++j) { const LAS unsigned char* va = Vb + (32 * jb + 16 * t2) * RT_P + vlane + 64 * (2 * eh + j); acc[j] = MFMA32(cat8(tr_read(va), tr_read(va + 8 * RT_P)), pb[t2], acc[j]); }
        }
        __syncthreads();
        LAS float* E = (LAS float*)L;
#pragma unroll
        for (int j = 0; j < 2; ++j)
#pragma unroll
            for (int r4 = 0; r4 < 4; ++r4) *(LAS f32x4*)(E + (32 * ib + l31) * E_PITCH + 32 * (2 * eh + j) + 8 * r4 + 4 * hi) = (f32x4){acc[j][4 * r4], acc[j][4 * r4 + 1], acc[j][4 * r4 + 2], acc[j][4 * r4 + 3]};
        __syncthreads();
        { const int row = tid >> 2, qtr = tid & 3; const LAS float* er = E + row * E_PITCH + 32 * qtr; f32x4 v[8]; float ss = 0.f;
#pragma unroll
          for (int j = 0; j < 8; ++j) { v[j] = *(const LAS f32x4*)(er + 4 * j); ss += (v[j][0] * v[j][0] + v[j][1] * v[j][1]) + (v[j][2] * v[j][2] + v[j][3] * v[j][3]); }
          ss += __shfl_xor(ss, 1); ss += __shfl_xor(ss, 2);
          const float rstd = 1.f / sqrtf(ss * (1.f / 128.f) + EPS);
          bf16_t* op = MIXED + (rowbase + row) * 2048 + h * 128 + 32 * qtr;
#pragma unroll
          for (int j = 0; j < 4; ++j) { const u32x4 gw = gwv[j]; const f32x4 a = v[2 * j], bq = v[2 * j + 1];
              u32x4 w; w.x = cvtpk(a[0] * rstd * silu(bflo(gw.x)), a[1] * rstd * silu(bfhi(gw.x))); w.y = cvtpk(a[2] * rstd * silu(bflo(gw.y)), a[3] * rstd * silu(bfhi(gw.y)));
              w.z = cvtpk(bq[0] * rstd * silu(bflo(gw.z)), bq[1] * rstd * silu(bfhi(gw.z))); w.w = cvtpk(bq[2] * rstd * silu(bflo(gw.w)), bq[3] * rstd * silu(bfhi(gw.w)));
              *(u32x4*)(op + 8 * j) = w; }
        }
        __syncthreads();
    }
#undef RO_LOAD
}
constexpr int LR_XC = 0, LR_XCB = 49664, LR_GA = 76288, LR_LX = 76288, LR_XP = 97, LR_BP = 208;
constexpr int LR_CST = 125952;
__device__ __forceinline__ void lru_phase(LAS unsigned char* L, const Params& p, int layer, const bf16_t* PROJ, const bf16_t* LW, const float* C8, unsigned* HA, float* HEND, float* AEND, int bid, int G) {
    int tid = threadIdx.x; asm volatile("" : "+v"(tid)); const int lane = tid & 63, wid = __builtin_amdgcn_readfirstlane(tid >> 6), l31 = lane & 31, hi = lane >> 5;
    LAS float* XC = (LAS float*)(L + LR_XC); LAS unsigned char* XCB = L + LR_XCB; LAS float* GA = (LAS float*)(L + LR_GA); LAS unsigned char* LX = L + LR_LX; LAS float* CST = (LAS float*)(L + LR_CST);
    u32x4 lxr[4];
#define LRU_LOAD(it_) { const int jb_ = (it_) & 7, n_ = ((it_) >> 3) & 63, b_ = (it_) >> 9; const size_t rb_ = (size_t)b_ * SEQ + (size_t)n_ * 128; \
        _Pragma("unroll") for (int i_ = 0; i_ < 4; ++i_) { const int id = tid + 512 * i_; const int row = id / 12, ch = id - row * 12; lxr[i_] = (u32x4){0u, 0u, 0u, 0u}; \
            if (id < 131 * 12 && (n_ > 0 || row >= 3)) lxr[i_] = *(const u32x4*)(PROJ + (rb_ + row - 3) * DIN + C_LX + 96 * jb_ + 8 * ch); } }
    int it = bid;
    if (it < 1024) LRU_LOAD(it);
    for (; it < 1024; it += G) {
        const int jb = it & 7, n = (it >> 3) & 63, b = it >> 9;
        const size_t rowbase = (size_t)b * SEQ + (size_t)n * 128;
#pragma unroll
        for (int i = 0; i < 4; ++i) { const int id = tid + 512 * i; const int row = id / 12, ch = id - row * 12; if (id < 131 * 12) *(LAS u32x4*)(LX + row * 192 + ch * 16) = lxr[i]; }
        for (int e = tid; e < 768; e += 512) { const int a = e / 96, c = e - a * 96; float v;
            if (a == 0) v = p.ba[layer * 768 + 96 * jb + c]; else if (a == 1) v = p.bx[layer * 768 + 96 * jb + c]; else if (a == 2) v = C8[layer * 768 + 96 * jb + c];
            else if (a < 7) v = p.conv_w[(size_t)layer * 4 * 768 + (a - 3) * 768 + 96 * jb + c]; else v = p.conv_b[layer * 768 + 96 * jb + c];
            CST[e] = v; }
        const int tb = wid & 3, half = wid >> 2; const int cb0 = half == 0 ? 0 : 2, cb1 = half == 0 ? 2 : 3;
        const bf16_t* WA = LW + ((size_t)((layer * 2 + 0) * 8 + jb)) * 9216; const bf16_t* WX = LW + ((size_t)((layer * 2 + 1) * 8 + jb)) * 9216;
        bf16x8 fa[6], fx[6];
#pragma unroll
        for (int s = 0; s < 6; ++s) { fa[s] = *(const bf16x8*)(WA + (32 * cb0 + l31) * 96 + 16 * s + 8 * hi); fx[s] = *(const bf16x8*)(WX + (32 * cb0 + l31) * 96 + 16 * s + 8 * hi); }
        __syncthreads();
        if (it + G < 1024) LRU_LOAD(it + G);
        if (tid < 480) { const int c = tid % 96, grp = tid / 96; const int t0 = grp * 26, t1 = t0 + 26 < 128 ? t0 + 26 : 128;
            const float w0 = CST[3 * 96 + c], w1 = CST[4 * 96 + c], w2 = CST[5 * 96 + c], w3 = CST[6 * 96 + c], bs = CST[7 * 96 + c];
            const LAS unsigned short* lx = (const LAS unsigned short*)(LX + c * 2);
            float x0 = __uint_as_float((unsigned)lx[(t0 + 0) * 96] << 16), x1 = __uint_as_float((unsigned)lx[(t0 + 1) * 96] << 16), x2 = __uint_as_float((unsigned)lx[(t0 + 2) * 96] << 16);
            for (int t = t0; t < t1; ++t) { const float x3 = __uint_as_float((unsigned)lx[(t + 3) * 96] << 16);
                const float acc = bs + x0 * w0 + x1 * w1 + x2 * w2 + x3 * w3;
                XC[t * LR_XP + c] = acc; *(LAS unsigned short*)(XCB + t * LR_BP + c * 2) = (unsigned short)(cvtpk(acc, 0.f) & 0xffffu);
                x0 = x1; x1 = x2; x2 = x3; } }
        __syncthreads();
        { const int tok = 32 * tb + l31;
          for (int cbk = cb0; cbk < cb1; ++cbk) {
              f32x16 aR, aI;
#pragma unroll
              for (int r = 0; r < 16; ++r) { aR[r] = 0.f; aI[r] = 0.f; }
              if (cbk != cb0) {
#pragma unroll
                  for (int s = 0; s < 6; ++s) { fa[s] = *(const bf16x8*)(WA + (32 * cbk + l31) * 96 + 16 * s + 8 * hi); fx[s] = *(const bf16x8*)(WX + (32 * cbk + l31) * 96 + 16 * s + 8 * hi); }
              }
#pragma unroll
              for (int s = 0; s < 6; ++s) { const bf16x8 B = *(const LAS bf16x8*)(XCB + tok * LR_BP + (16 * s + 8 * hi) * 2); aR = MFMA32(fa[s], B, aR); aI = MFMA32(fx[s], B, aI); }
#pragma unroll
              for (int r = 0; r < 16; ++r) { const int cc = 32 * cbk + crow(r, hi);
                  const float rr = sigm(aR[r] + CST[cc]), ii = sigm(aI[r] + CST[96 + cc]);
                  const float log_a = rr * CST[192 + cc]; const float a = __expf(log_a); const float x2 = 2.f * log_a;
                  const float m1s = -x2 * (1.f + x2 * (0.5f + x2 * (0.16666667f + x2 * (0.041666668f + x2 * 0.008333334f))));
                  const float m1 = x2 < -0.25f ? 1.f - a * a : m1s;
                  const float mult = __builtin_amdgcn_sqrtf(m1);
                  const float xcv = XC[tok * LR_XP + cc];
                  GA[tok * LR_XP + cc] = a; XC[tok * LR_XP + cc] = mult * (ii * xcv); }
          }
        }
        __syncthreads();
        LAS float* SEGA = (LAS float*)XCB; LAS float* SEGH = SEGA + 4 * 96;
        const int sc_c = tid % 96, seg = tid / 96;
        float av[32], bv[32];
        if (tid < 384) {
#pragma unroll
            for (int t = 0; t < 32; ++t) { av[t] = GA[(32 * seg + t) * LR_XP + sc_c]; bv[t] = XC[(32 * seg + t) * LR_XP + sc_c]; }
            float A = 1.f, H = 0.f;
#pragma unroll
            for (int t = 0; t < 32; ++t) { H = av[t] * H + bv[t]; A *= av[t]; av[t] = A; bv[t] = H; }
            SEGA[seg * 96 + sc_c] = A; SEGH[seg * 96 + sc_c] = H; }
        __syncthreads();
        if (tid < 384) { float Hin = 0.f, Ain = 1.f;
            for (int s2 = 0; s2 < seg; ++s2) { Hin = SEGA[s2 * 96 + sc_c] * Hin + SEGH[s2 * 96 + sc_c]; Ain *= SEGA[s2 * 96 + sc_c]; }
            unsigned* dst = HA + (rowbase + 32 * seg) * 768 + 96 * jb + sc_c;
#pragma unroll
            for (int t = 0; t < 32; ++t) { const float Hf = bv[t] + av[t] * Hin, Af = av[t] * Ain; dst[(size_t)t * 768] = cvtpk(Hf, Af);
                if (t == 31 && seg == 3) { HEND[(size_t)(b * 64 + n) * 768 + 96 * jb + sc_c] = Hf; AEND[(size_t)(b * 64 + n) * 768 + 96 * jb + sc_c] = Af; } } }
        __syncthreads();
    }
#undef LRU_LOAD
}

#define XB_TMO      128
#define XB_XCNT(j)  (256  + 64 * (j))
#define XB_XSUB(j)  (1280 + 64 * (j))
#define XB_XGEN(j)  (2304 + 64 * (j))
#define XB_TOP      3328
#define XB_TOPGEN   3392
#define XCD_BAR_WORDS 3456
#define XB_SPIN_CAP (1u << 18)

__device__ __forceinline__ unsigned xb_ld(unsigned* p)              { return __hip_atomic_load(p, __ATOMIC_RELAXED, __HIP_MEMORY_SCOPE_AGENT); }
__device__ __forceinline__ unsigned xb_add(unsigned* p, unsigned v) { return __hip_atomic_fetch_add(p, v, __ATOMIC_RELAXED, __HIP_MEMORY_SCOPE_AGENT); }
__device__ __forceinline__ unsigned xb_xcc_id() { return (unsigned)__builtin_amdgcn_s_getreg((3 << 11) | 20) & 0xFu; }
#define XB_SPIN(cond, bar) do { unsigned _sp = 0; while (cond) { __builtin_amdgcn_s_sleep(1); \
    if ((++_sp & 255u) == 0u) { if (xb_ld(&(bar)[XB_TMO])) break; if (_sp > XB_SPIN_CAP) { atomicAdd(&(bar)[XB_TMO], 1u); break; } } } } while (0)

struct XcdBarrier {
    unsigned* bar; unsigned x;
    volatile LAS unsigned* st;
};

__device__ __forceinline__ XcdBarrier xcd_barrier_post(unsigned* bar, volatile LAS unsigned* st) {
    XcdBarrier b; b.bar = bar; b.x = xb_xcc_id(); b.st = st;
    if (threadIdx.x == 0) (void)xb_add(&bar[XB_XCNT(b.x)], 1u);
    return b;
}
__device__ __forceinline__ void xcd_barrier_complete(unsigned* bar, unsigned x, unsigned& nloc, unsigned& nx) {
    const unsigned G = gridDim.x * gridDim.y * gridDim.z;
    unsigned sum, cnt, mine, sp = 0u;
    for (;;) {
        sum = 0u; cnt = 0u; mine = 0u;
#pragma unroll
        for (unsigned j = 0; j < 16; ++j) { const unsigned c = xb_ld(&bar[XB_XCNT(j)]); sum += c; cnt += (c > 0u) ? 1u : 0u; mine = (j == x) ? c : mine; }
        if (sum == G) break;
        __builtin_amdgcn_s_sleep(1);
        if ((++sp & 255u) == 0u) { if (xb_ld(&bar[XB_TMO])) break; if (sp > XB_SPIN_CAP) { atomicAdd(&bar[XB_TMO], 1u); break; } }
    }
    nloc = mine > 0u ? mine : 1u; nx = cnt > 0u ? cnt : 1u;
}

__device__ __forceinline__ void xcd_barrier(const XcdBarrier& b) {
    asm volatile("s_waitcnt vmcnt(0)" ::: "memory");
    __syncthreads();
    if (threadIdx.x == 0) {
        unsigned* bar = b.bar;
        __builtin_amdgcn_s_waitcnt(0);
        unsigned nloc = b.st[0], nx = b.st[1];
        if (nloc == 0u) { xcd_barrier_complete(bar, b.x, nloc, nx); b.st[0] = nloc; b.st[1] = nx; }
        const unsigned old = xb_add(&bar[XB_XSUB(b.x)], 1u);
        const unsigned gen = old / nloc;
        if (old + 1u == (gen + 1u) * nloc) {
            __builtin_amdgcn_fence(__ATOMIC_RELEASE, "agent");
            asm volatile("s_waitcnt vmcnt(0)" ::: "memory");
            const unsigned og = xb_add(&bar[XB_TOP], 1u);
            const unsigned tg = og / nx;
            if (og + 1u == (tg + 1u) * nx) xb_add(&bar[XB_TOPGEN], 1u);
            else XB_SPIN(xb_ld(&bar[XB_TOPGEN]) == tg, bar);
            __builtin_amdgcn_fence(__ATOMIC_ACQUIRE, "agent");
            xb_add(&bar[XB_XGEN(b.x)], 1u);
            asm volatile("s_waitcnt vmcnt(0)" ::: "memory");
        } else {
            XB_SPIN(xb_ld(&bar[XB_XGEN(b.x)]) == gen, bar);
            __builtin_amdgcn_fence(__ATOMIC_ACQUIRE, "agent");
            asm volatile("s_waitcnt vmcnt(0)" ::: "memory");
        }
    }
    __syncthreads();
}

#ifndef REP_P0
#define REP_P0 1
#endif
#ifndef REP_G1
#define REP_G1 1
#endif
#ifndef REP_AT
#define REP_AT 1
#endif
#ifndef REP_RK
#define REP_RK 1
#endif
#ifndef REP_LR
#define REP_LR 1
#endif
#ifndef REP_SC
#define REP_SC 1
#endif
#ifndef REP_RO
#define REP_RO 1
#endif
#ifndef REP_G2
#define REP_G2 1
#endif
#ifndef REP_FN
#define REP_FN 1
#endif
__global__ void __launch_bounds__(512) mega_fwd(Params p) {
    extern __shared__ __attribute__((aligned(16))) unsigned char lds_raw[];
    LAS unsigned char* L = (LAS unsigned char*)lds_raw;
    cg::grid_group grid = cg::this_grid();
    unsigned char* ws = p.ws;
    const int G = gridDim.x, bid = blockIdx.x, NGW = G * 8, NT = G * 512;
#define TIDS int tid = threadIdx.x; asm volatile("" : "+v"(tid)); const int lane = tid & 63, wave = tid >> 6, gw = bid * 8 + wave, gt = bid * 512 + tid; (void)lane; (void)gw; (void)gt;
    bf16_t* XB = (bf16_t*)(ws + WS_XB); bf16_t* MIXED = (bf16_t*)p.out;     bf16_t* PROJ = (bf16_t*)(ws + WS_PROJ); bf16_t* Y = (bf16_t*)(ws + WS_Y);
    float* KV = (float*)(ws + WS_KV); bf16_t* SP = (bf16_t*)(ws + WS_SP); unsigned* HA = (unsigned*)(ws + WS_HL);
    float* HEND = (float*)(ws + WS_HEND); float* AEND = (float*)(ws + WS_AEND); float* CARRY = (float*)(ws + WS_CARRY);
    float* RSTD = (float*)(ws + WS_RSTD); const bf16_t* LW = (const bf16_t*)(ws + WS_LRUW);
    const int lo = p.ph_lo, hi = p.ph_hi;
    volatile LAS unsigned* bst = (volatile LAS unsigned*)(L + LDS_BARST);
    if (threadIdx.x < 8) bst[threadIdx.x] = 0u;
    __syncthreads();
    XcdBarrier xbar; xbar.bar = (unsigned*)(ws + WS_BAR); xbar.x = 0; xbar.st = bst;
    if (hi - lo > 1) xbar = xcd_barrier_post((unsigned*)(ws + WS_BAR), bst);
    unsigned* cen = (unsigned*)(ws + WS_BAR) + 3584;
    if (threadIdx.x == 0 && hi - lo > 1) { const unsigned xcc = xb_xcc_id(); bst[2] = xcc; bst[3] = xb_add(&cen[xcc], 1u); }
#define IN(k) (lo <= (k) && (k) < hi)
#define SEAM(k) do { if (IN(k) && IN((k) + 1)) { if (p.ph_hi > 1000) grid.sync(); else xcd_barrier(xbar); } } while (0)
    if (IN(0)) { for (int rep_ = 0; rep_ < REP_P0; ++rep_) phase0(p, L); }
    SEAM(0);
    int vid = bid;
    if (hi - lo > 1) {
        if (threadIdx.x == 0) { bool ok = (G % 8) == 0; for (int j = 0; j < 16; ++j) { const unsigned cj = xb_ld(&cen[j]); ok = ok && (cj == (j < 8 ? (unsigned)(G / 8) : 0u)); }
            bst[4] = ok ? (bst[2] + 8u * bst[3]) : (unsigned)bid; }
        __syncthreads();
        vid = (int)bst[4];
    }
    vid = __builtin_amdgcn_readfirstlane(vid);
#pragma unroll 1
    for (int layer = 0; layer < 2; ++layer) {
        const int kb_ = 1 + 6 * layer;
        float* SSQ = (float*)(ws + WS_SSQ) + layer * M;
        if (IN(kb_ + 0)) for (int rep_ = 0; rep_ < REP_G1; ++rep_) {
            pg8::Gemm g{XB, (const bf16_t*)(ws + WS_WIN) + (size_t)layer * DIN * 2048, M, DIN, 2048}; pg8::StaticOrder S; S.init(M, DIN, G, vid);
            pg8::EpiProj E{PROJ, RSTD, (const float*)(ws + WS_COSR), (const float*)(ws + WS_SINR), (const float*)(ws + WS_COSD), (const float*)(ws + WS_SIND)};
            pg8::gemm_phase<pg8::EpiProj, pg8::StaticOrder, true, true>(L, g, S, E);
        }
        SEAM(kb_ + 0);
        if (IN(kb_ + 1)) {
            float d1 = 0.f, d2 = 0.f;
            for (int i = 0; i < 64; ++i) { d1 += p.lq1[layer * 64 + i] * p.lk1[layer * 64 + i]; d2 += p.lq2[layer * 64 + i] * p.lk2[layer * 64 + i]; }
            const float lam_init = 0.8f - 0.6f * expf(-0.3f * (float)layer);
            const float lam = expf(d1) - expf(d2) + lam_init;
            for (int rep_ = 0; rep_ < REP_AT; ++rep_) for (int pi = vid; pi < 256; pi += G) { const int bh = pi & 7, pp = pi >> 3;
                attn_item(L, PROJ, MIXED, p.subln_g + layer * 128, bh >> 2, bh & 3, 63 - pp, lam, 1.f - lam_init);
                attn_item(L, PROJ, MIXED, p.subln_g + layer * 128, bh >> 2, bh & 3, pp, lam, 1.f - lam_init); }
            ret_kv_phase(L, PROJ, KV, bid, G);
            for (int rep_ = 0; rep_ < REP_LR; ++rep_) lru_phase(L, p, layer, PROJ, LW, (const float*)(ws + WS_C8), HA, HEND, AEND, bid, G);
        }
        SEAM(kb_ + 1);
        if (IN(kb_ + 2)) for (int rep_ = 0; rep_ < REP_SC; ++rep_) {
            TIDS
            typedef float f32x2 __attribute__((ext_vector_type(2)));
            for (int idx = gt; idx < 12 * 8192; idx += NT) { const int bh = idx >> 13, ed = (idx & 8191) * 2; const float cd = fexp2(128.f * ret_log2g(bh % 6));
                const float* src = KV + (size_t)bh * 64 * 16384 + ed; bf16_t* dst = SP + (size_t)bh * 64 * 16384 + ed; float st0 = 0.f, st1 = 0.f;
                for (int n0 = 0; n0 < 64; n0 += 8) { f32x2 v[8];
#pragma unroll
                    for (int i = 0; i < 8; ++i) v[i] = __builtin_nontemporal_load((const f32x2*)(src + (size_t)(n0 + i) * 16384));
#pragma unroll
                    for (int i = 0; i < 8; ++i) { *(unsigned*)(dst + (size_t)(n0 + i) * 16384) = cvtpk(st0, st1); st0 = st0 * cd + v[i][0]; st1 = st1 * cd + v[i][1]; } } }
            for (int idx = gt; idx < 2 * 768; idx += NT) { const int b = idx / 768, c = idx - b * 768; float H = 0.f;
                for (int n0 = 0; n0 < 64; n0 += 8) { float a[8], hh[8];
#pragma unroll
                    for (int i = 0; i < 8; ++i) { a[i] = AEND[(size_t)(b * 64 + n0 + i) * 768 + c]; hh[i] = HEND[(size_t)(b * 64 + n0 + i) * 768 + c]; }
#pragma unroll
                    for (int i = 0; i < 8; ++i) { CARRY[(size_t)(b * 64 + n0 + i) * 768 + c] = H; H = a[i] * H + hh[i]; } } }
        }
        SEAM(kb_ + 2);
        if (IN(kb_ + 3)) for (int rep_ = 0; rep_ < REP_RO; ++rep_) {
            TIDS
            ret_out_phase(L, PROJ, SP, MIXED, bid, G);
            for (int idx = gt; idx < M * 96; idx += NT) { const int m = idx / 96, c = (idx - m * 96) * 8; const int bn = m >> 7;
                const u32x4 h0 = __builtin_nontemporal_load((const u32x4*)(HA + (size_t)m * 768 + c)), h1 = __builtin_nontemporal_load((const u32x4*)(HA + (size_t)m * 768 + c + 4)), lg = __builtin_nontemporal_load((const u32x4*)(PROJ + (size_t)m * DIN + C_LG + c));
                const f32x4 c0 = *(const f32x4*)(CARRY + (size_t)bn * 768 + c), c1 = *(const f32x4*)(CARRY + (size_t)bn * 768 + c + 4);
                u32x4 w;
                w.x = cvtpk((bflo(h0.x) + bfhi(h0.x) * c0[0]) * silu(bflo(lg.x)), (bflo(h0.y) + bfhi(h0.y) * c0[1]) * silu(bfhi(lg.x)));
                w.y = cvtpk((bflo(h0.z) + bfhi(h0.z) * c0[2]) * silu(bflo(lg.y)), (bflo(h0.w) + bfhi(h0.w) * c0[3]) * silu(bfhi(lg.y)));
                w.z = cvtpk((bflo(h1.x) + bfhi(h1.x) * c1[0]) * silu(bflo(lg.z)), (bflo(h1.y) + bfhi(h1.y) * c1[1]) * silu(bfhi(lg.z)));
                w.w = cvtpk((bflo(h1.z) + bfhi(h1.z) * c1[2]) * silu(bflo(lg.w)), (bflo(h1.w) + bfhi(h1.w) * c1[3]) * silu(bfhi(lg.w)));
                *(u32x4*)(MIXED + (size_t)m * 2048 + 1280 + c) = w; }
        }
        SEAM(kb_ + 3);
        if (IN(kb_ + 4)) for (int rep_ = 0; rep_ < REP_G2; ++rep_) {
            pg8::Gemm g{MIXED, (const bf16_t*)(ws + WS_WOUT) + (size_t)layer * 2048 * 2048, M, 2048, 2048}; pg8::StaticOrder S; S.init(M, 2048, G, vid);
            pg8::EpiY E{Y, rep_ == 0 ? SSQ : (float*)(ws + WS_KV)};
            pg8::gemm_phase<pg8::EpiY, pg8::StaticOrder, true, true>(L, g, S, E);
        }
        SEAM(kb_ + 4);
        if (IN(kb_ + 5)) for (int rep_ = 0; rep_ < REP_FN; ++rep_) {
            TIDS
            const float* pg = p.post_g + layer * 2048;
            for (int m = gw; m < M; m += NGW) {
                const float rs = 1.f / sqrtf(SSQ[m] * (1.f / 2048.f) + EPS); float s = 0.f; f32x4 xn[8];
#pragma unroll
                for (int j = 0; j < 4; ++j) { const int col = j * 512 + lane * 8; const u32x4 yw = __builtin_nontemporal_load((const u32x4*)(Y + (size_t)m * 2048 + col));
                    f32x4 x0, x1;
                    if (layer == 0) { x0 = __builtin_nontemporal_load((const f32x4*)(p.x + (size_t)m * 2048 + col)); x1 = __builtin_nontemporal_load((const f32x4*)(p.x + (size_t)m * 2048 + col + 4)); }
                    else { const u32x4 xw = *(const u32x4*)(XB + (size_t)m * 2048 + col); x0 = (f32x4){bflo(xw.x), bfhi(xw.x), bflo(xw.y), bfhi(xw.y)}; x1 = (f32x4){bflo(xw.z), bfhi(xw.z), bflo(xw.w), bfhi(xw.w)}; }
                    const f32x4 g0 = *(const f32x4*)(pg + col), g1 = *(const f32x4*)(pg + col + 4);
                    f32x4 a, bq; a[0] = x0[0] + bflo(yw.x) * rs * g0[0]; a[1] = x0[1] + bfhi(yw.x) * rs * g0[1]; a[2] = x0[2] + bflo(yw.y) * rs * g0[2]; a[3] = x0[3] + bfhi(yw.y) * rs * g0[3];
                    bq[0] = x1[0] + bflo(yw.z) * rs * g1[0]; bq[1] = x1[1] + bfhi(yw.z) * rs * g1[1]; bq[2] = x1[2] + bflo(yw.w) * rs * g1[2]; bq[3] = x1[3] + bfhi(yw.w) * rs * g1[3];
                    xn[2 * j] = a; xn[2 * j + 1] = bq; s += (a[0] * a[0] + a[1] * a[1]) + (a[2] * a[2] + a[3] * a[3]) + (bq[0] * bq[0] + bq[1] * bq[1]) + (bq[2] * bq[2] + bq[3] * bq[3]);
                    if (layer != 0) { __builtin_nontemporal_store(a, (f32x4*)(p.out + (size_t)m * 2048 + col)); __builtin_nontemporal_store(bq, (f32x4*)(p.out + (size_t)m * 2048 + col + 4)); } }
                if (layer == 0) { s = wave_sum(s); if (lane == 0) RSTD[m] = 1.f / sqrtf(s * (1.f / 2048.f) + EPS);
#pragma unroll
                    for (int j = 0; j < 4; ++j) { const f32x4 a = xn[2 * j], bq = xn[2 * j + 1]; u32x4 w; w.x = cvtpk(a[0], a[1]); w.y = cvtpk(a[2], a[3]); w.z = cvtpk(bq[0], bq[1]); w.w = cvtpk(bq[2], bq[3]);
                        *(u32x4*)(XB + (size_t)m * 2048 + j * 512 + lane * 8) = w; } }
            }
        }
        SEAM(kb_ + 5);
    }
#undef IN
#undef SEAM
}

#ifndef MK_MULTI
#define MK_MULTI 0
#endif
constexpr int N_PHASES = 13;
extern "C" void kernel_launch(void* const* d_in, const int* in_sizes, int n_in, void* d_out, int out_size, void* d_ws, size_t ws_size, hipStream_t stream) {
    static int grid = 0;
    if (grid == 0) {
        if (n_in != 18 || ws_size < WS_END) { fprintf(stderr, "kernel_launch: unexpected inputs (n_in %d, ws %zu)\n", n_in, ws_size); grid = -1; return; }
        int dev = 0, cus = 0, per_cu = 0;
        hipGetDevice(&dev); hipDeviceGetAttribute(&cus, hipDeviceAttributeMultiprocessorCount, dev);
        hipFuncSetAttribute((const void*)mega_fwd, hipFuncAttributeMaxDynamicSharedMemorySize, LDS_BYTES);
        if (hipOccupancyMaxActiveBlocksPerMultiprocessor(&per_cu, (const void*)mega_fwd, 512, LDS_BYTES) != hipSuccess || per_cu < 1) per_cu = 1;
        (void)hipGetLastError();
        grid = cus * per_cu;
    }
    if (grid < 0) return;
    Params p{};
    p.x = (const float*)d_in[0]; p.pos = (const int*)d_in[1]; p.pre_g = (const float*)d_in[2]; p.w_in = (const float*)d_in[3];
    p.lq1 = (const float*)d_in[4]; p.lk1 = (const float*)d_in[5]; p.lq2 = (const float*)d_in[6]; p.lk2 = (const float*)d_in[7];
    p.subln_g = (const float*)d_in[8]; p.conv_w = (const float*)d_in[9]; p.conv_b = (const float*)d_in[10]; p.wa = (const float*)d_in[11]; p.ba = (const float*)d_in[12];
    p.wx = (const float*)d_in[13]; p.bx = (const float*)d_in[14]; p.lru_lam = (const float*)d_in[15]; p.w_out = (const float*)d_in[16]; p.post_g = (const float*)d_in[17];
    p.out = (float*)d_out; p.ws = (unsigned char*)d_ws;
#if MK_MULTI
    for (int ph = 0; ph < N_PHASES; ++ph) { p.ph_lo = ph; p.ph_hi = ph + 1; hipLaunchKernelGGL(mega_fwd, dim3(grid), dim3(512), LDS_BYTES, stream, p); }
#else
    p.ph_lo = 0; p.ph_hi = N_PHASES;
    if (hipMemsetAsync((char*)d_ws + WS_BAR, 0, WS_BAR_BYTES, stream) != hipSuccess) { fprintf(stderr, "kernel_launch: memset of barrier words failed\n"); return; }
    void* args[] = {&p};
    hipError_t e = hipLaunchCooperativeKernel((const void*)mega_fwd, dim3(grid), dim3(512), args, LDS_BYTES, stream);
    if (e != hipSuccess) fprintf(stderr, "cooperative launch failed: %s (grid %d)\n", hipGetErrorString(e), grid);
#endif
}
```

```cpp
#include <hip/hip_runtime.h>
#include <hip/hip_cooperative_groups.h>
#include <cstdio>
#include <cstdint>
namespace cg = cooperative_groups;
namespace pg8 {
#define PG8_LAS __attribute__((address_space(3)))
typedef unsigned short bf16_t;
typedef short bf16x8 __attribute__((ext_vector_type(8)));
typedef float f32x4 __attribute__((ext_vector_type(4)));
typedef unsigned u32x4 __attribute__((ext_vector_type(4)));
constexpr int BM = 256, BK = 64, HALF = 128, HTB = HALF * BK * 2  , STAGE_BYTES = 8 * HTB, NXCD = 8, WGM = 4;

__host__ __device__ __forceinline__ int lds_byte(int r, int c) { const int st = (r >> 4) * 2 + (c >> 5), rr = r & 15, cc = c & 31, ob = rr * 64 + cc * 2; return st * 1024 + (ob ^ (((ob >> 9) & 1) << 5)); }
__host__ __device__ __forceinline__ void stage_rc(int b, int& R, int& C) { const int st = b / 1024, sb = b % 1024, swz = sb ^ (((sb >> 9) & 1) << 5); R = (st >> 1) * 16 + swz / 64; C = (st & 1) * 32 + (swz % 64) / 2; }
__host__ __device__ __forceinline__ int perm32(int rho) { const int n = rho >> 4, i = rho & 15; return 8 * (i >> 2) + 4 * n + (i & 3); }

struct Unit { int pm, pn; };
struct Gemm { const bf16_t* A; const bf16_t* Bt; int M, N, K; };

struct StaticOrder {
    int nM, nN, nwg, G, c;
    __host__ __device__ void init(int M, int N, int G_, int c_) { nM = M / BM; nN = N / BM; nwg = nM * nN; G = G_; c = c_; }
    __host__ __device__ bool next(int i, Unit& u) const {
        const long L = (long)i * G + c; if (L >= nwg) return false;
        int wgid = (int)L; { const int q = nwg / NXCD, r = nwg % NXCD, xcd = wgid % NXCD, off = wgid / NXCD; wgid = (xcd < r ? xcd * (q + 1) : r * (q + 1) + (xcd - r) * q) + off; }
        const int nig = WGM * nN, gid = wgid / nig, fm = gid * WGM, gsz = (nM - fm) < WGM ? (nM - fm) : WGM;
        u.pm = fm + ((wgid % nig) % gsz); u.pn = (wgid % nig) / gsz; return true;
    }
    __device__ __forceinline__ void a_ready(const Unit&) const {}
    __device__ __forceinline__ void done(const Unit&) const {}
};
__device__ __forceinline__ unsigned cvt_pk_bf16(float lo, float hi) { unsigned r; asm volatile("v_cvt_pk_bf16_f32 %0, %1, %2" : "=v"(r) : "v"(lo), "v"(hi)); return r; }
typedef float f32x2 __attribute__((ext_vector_type(2)));
typedef unsigned u32x4 __attribute__((ext_vector_type(4)));
struct EpiProj {
    static constexpr bool PERM = true, AFTER_DRAIN = false;
    bf16_t* O; const float* rstd; const float* cosR; const float* sinR; const float* cosD; const float* sinD;
    __device__ __forceinline__ void operator()(const f32x4 (&acc)[2][2][4][2], const Unit& u, int wr, int wc, int fr, int fq) const {
        const int row0 = u.pm * BM + wr * 64 + fr; const int colt = u.pn * BM;
        int mode = 0; float sc = 1.f;
        if (colt < 768) { mode = 1; } else if (colt < 1536) { mode = 1; sc = 0.08838834764831845f; }
        else if (colt >= 3072 && colt < 3584) { mode = 2; sc = 0.125f * 1.4426950408889634f; } else if (colt >= 3584 && colt < 4096) { mode = 2; }
        const int colw = colt + wc * 32 + 8 * fq;
#pragma unroll
        for (int ai = 0; ai < 2; ++ai)
#pragma unroll
            for (int m = 0; m < 4; ++m) { const int row = row0 + ai * HALF + m * 16; const float rs = rstd[row] * sc;
#pragma unroll
                for (int bj = 0; bj < 2; ++bj) { const int col0 = colw + bj * HALF; f32x4 v0 = acc[ai][bj][m][0] * rs, v1 = acc[ai][bj][m][1] * rs;
                    if (mode != 0) {
                        f32x4 cs, sn;
                        if (mode == 1) { const int i0 = (col0 & 127) >> 1; cs = *(const f32x4*)(cosR + (size_t)row * 64 + i0); sn = *(const f32x4*)(sinR + (size_t)row * 64 + i0); }
                        else { const int i0 = (col0 & 63) >> 1; cs = *(const f32x4*)(cosD + (size_t)row * 32 + i0); sn = *(const f32x4*)(sinD + (size_t)row * 32 + i0); }
                        f32x4 w0, w1;
                        w0[0] = v0[0] * cs[0] - v0[1] * sn[0]; w0[1] = v0[1] * cs[0] + v0[0] * sn[0];
                        w0[2] = v0[2] * cs[1] - v0[3] * sn[1]; w0[3] = v0[3] * cs[1] + v0[2] * sn[1];
                        w1[0] = v1[0] * cs[2] - v1[1] * sn[2]; w1[1] = v1[1] * cs[2] + v1[0] * sn[2];
                        w1[2] = v1[2] * cs[3] - v1[3] * sn[3]; w1[3] = v1[3] * cs[3] + v1[2] * sn[3];
                        v0 = w0; v1 = w1;
                    }
                    u32x4 w; w.x = cvt_pk_bf16(v0[0], v0[1]); w.y = cvt_pk_bf16(v0[2], v0[3]); w.z = cvt_pk_bf16(v1[0], v1[1]); w.w = cvt_pk_bf16(v1[2], v1[3]);
                    *(u32x4*)(O + (size_t)row * 6656 + col0) = w; } }
    }
};
struct EpiY {
    static constexpr bool PERM = true, AFTER_DRAIN = false;
    bf16_t* Y; float* ssq;
    __device__ __forceinline__ void operator()(const f32x4 (&acc)[2][2][4][2], const Unit& u, int wr, int wc, int fr, int fq) const {
        const int row0 = u.pm * BM + wr * 64 + fr; const int colw = u.pn * BM + wc * 32 + 8 * fq;
#pragma unroll
        for (int ai = 0; ai < 2; ++ai)
#pragma unroll
            for (int m = 0; m < 4; ++m) { const int row = row0 + ai * HALF + m * 16; float s = 0.f;
#pragma unroll
                for (int bj = 0; bj < 2; ++bj) { const f32x4 v0 = acc[ai][bj][m][0], v1 = acc[ai][bj][m][1];
                    s += (v0[0] * v0[0] + v0[1] * v0[1]) + (v0[2] * v0[2] + v0[3] * v0[3]) + (v1[0] * v1[0] + v1[1] * v1[1]) + (v1[2] * v1[2] + v1[3] * v1[3]);
                    u32x4 w; w.x = cvt_pk_bf16(v0[0], v0[1]); w.y = cvt_pk_bf16(v0[2], v0[3]); w.z = cvt_pk_bf16(v1[0], v1[1]); w.w = cvt_pk_bf16(v1[2], v1[3]);
                    *(u32x4*)(Y + (size_t)row * 2048 + colw + bj * HALF) = w; }
                s += __shfl_xor(s, 16); s += __shfl_xor(s, 32);
                if (fq == 0) unsafeAtomicAdd(ssq + row, s); }
    }
};
template <class Epi, class Sched, bool ALIGN_EPI = false, bool SP2 = false>
__device__ __forceinline__ void gemm_phase(PG8_LAS unsigned char* lds, const Gemm g, const Sched& S, const Epi& E) {
    int tid = threadIdx.x; asm volatile("" : "+v"(tid)); const int wid = __builtin_amdgcn_readfirstlane(tid >> 6), lane = tid & 63, wr = wid >> 2, wc = wid & 3, fr = lane & 15, fq = lane >> 4;
    const int K = g.K, nt = K / BK;
    unsigned voffA[2], voffB[2];
#pragma unroll
    for (int i = 0; i < 2; ++i) { int R, C; stage_rc(tid * 16 + i * 8192, R, C); const int Rb = Epi::PERM ? ((R & ~31) + perm32(R & 31)) : R;
        voffA[i] = (unsigned)(R * K + C) * 2u; voffB[i] = (unsigned)(Rb * K + C) * 2u; }
    const size_t kstep = (size_t)(BK * 2);
    const size_t hstep = (size_t)HALF * K * 2;
    const size_t tstep = 2 * hstep;
    const unsigned ldsw = (unsigned)wid * 1024u;
    const int aoff = lds_byte(wr * 64 + fr, fq * 8), boff = lds_byte(wc * 32 + fr, fq * 8);
#define PG8_SA(b, h) (((b) * 2 + (h)) * HTB)
#define PG8_SB(b, h) ((4 + (b) * 2 + (h)) * HTB)
#define PG8_STAGE(bufoff, gbase, voff) do { _Pragma("unroll") for (int _i = 0; _i < 2; ++_i) \
        __builtin_amdgcn_global_load_lds((const unsigned*)((const char*)(gbase) + (voff)[_i]), (PG8_LAS unsigned*)(lds + (bufoff) + ldsw + _i * 8192), 16, 0, 0); } while (0)
#define PG8_LDA(dst, b, h) do { _Pragma("unroll") for (int m = 0; m < 4; ++m) _Pragma("unroll") for (int k = 0; k < 2; ++k) dst[m][k] = *(const PG8_LAS bf16x8*)(lds + PG8_SA(b, h) + aoff + m * 2048 + k * 1024); } while (0)
#define PG8_LDB(dst, b, h) do { _Pragma("unroll") for (int n = 0; n < 2; ++n) _Pragma("unroll") for (int k = 0; k < 2; ++k) dst[n][k] = *(const PG8_LAS bf16x8*)(lds + PG8_SB(b, h) + boff + n * 2048 + k * 1024); } while (0)
#define PG8_MMA(ai, bj, At, Bt) do { __builtin_amdgcn_s_setprio(1); _Pragma("unroll") for (int m = 0; m < 4; ++m) _Pragma("unroll") for (int n = 0; n < 2; ++n) _Pragma("unroll") for (int k = 0; k < 2; ++k) \
        acc[ai][bj][m][n] = __builtin_amdgcn_mfma_f32_16x16x32_bf16(Bt[n][k], At[m][k], acc[ai][bj][m][n], 0, 0, 0); __builtin_amdgcn_s_setprio(0); } while (0)
#define PG8_WAIT_V(n) asm volatile("s_waitcnt vmcnt(" #n ")" ::: "memory")
#define PG8_WAIT_L(n) asm volatile("s_waitcnt lgkmcnt(" #n ")" ::: "memory")
#define PG8_BAR __builtin_amdgcn_s_barrier()
#define PG8_SCHED __builtin_amdgcn_sched_barrier(0)
    Unit cur, nxt; int ui = 0;
    if (!S.next(0, cur)) return;
    f32x4 acc[2][2][4][2];
#pragma unroll
    for (int a = 0; a < 2; ++a)
#pragma unroll
        for (int b = 0; b < 2; ++b)
#pragma unroll
            for (int m = 0; m < 4; ++m)
#pragma unroll
                for (int n = 0; n < 2; ++n) acc[a][b][m][n] = (f32x4){0.f, 0.f, 0.f, 0.f};
    bf16x8 At[4][2], B0[2][2], B1[2][2];
    const char* cA = (const char*)g.A + (size_t)cur.pm * tstep; const char* cB = (const char*)g.Bt + (size_t)cur.pn * tstep;
    S.a_ready(cur);
    if constexpr (SP2) {
        PG8_STAGE(PG8_SB(0, 0), cB, voffB); PG8_STAGE(PG8_SB(0, 1), cB + hstep, voffB); PG8_STAGE(PG8_SA(0, 0), cA, voffA); PG8_STAGE(PG8_SA(0, 1), cA + hstep, voffA);
        if (wr == 1) PG8_BAR;
        PG8_WAIT_V(2); PG8_BAR;
        PG8_STAGE(PG8_SB(1, 0), cB + kstep, voffB); PG8_STAGE(PG8_SA(1, 0), cA + kstep, voffA); PG8_STAGE(PG8_SB(1, 1), cB + hstep + kstep, voffB);
        PG8_WAIT_V(6); PG8_BAR;
    } else {
        PG8_STAGE(PG8_SB(0, 0), cB, voffB); PG8_STAGE(PG8_SA(0, 0), cA, voffA); PG8_STAGE(PG8_SB(0, 1), cB + hstep, voffB); PG8_STAGE(PG8_SA(0, 1), cA + hstep, voffA);
        if (wr == 1) PG8_BAR;
        PG8_WAIT_V(4); PG8_BAR;
        PG8_STAGE(PG8_SB(1, 0), cB + kstep, voffB); PG8_STAGE(PG8_SA(1, 0), cA + kstep, voffA); PG8_STAGE(PG8_SB(1, 1), cB + hstep + kstep, voffB);
        PG8_WAIT_V(6); PG8_BAR;
    }
    for (;;) {
        const bool has_next = S.next(ui + 1, nxt);
        const char* nA = has_next ? (const char*)g.A + (size_t)nxt.pm * tstep : cA; const char* nB = has_next ? (const char*)g.Bt + (size_t)nxt.pn * tstep : cB;
        for (int t = 0; t < nt; t += 2) {
            const bool last = (t == nt - 2);
            const char* a1 = cA + (size_t)(t + 1) * kstep;
            const char* a2 = last ? nA : cA + (size_t)(t + 2) * kstep; const char* b2 = last ? nB : cB + (size_t)(t + 2) * kstep;
            const char* a3 = a2 + kstep; const char* b3 = b2 + kstep;
            if (last && has_next) S.a_ready(nxt);
            if constexpr (SP2) {
            PG8_LDB(B0, 0, 0); PG8_LDB(B1, 0, 1); PG8_SCHED; PG8_LDA(At, 0, 0); PG8_STAGE(PG8_SA(1, 1), a1 + hstep, voffA);
            PG8_WAIT_V(8); PG8_WAIT_L(0); PG8_BAR; PG8_MMA(0, 0, At, B0); PG8_MMA(0, 1, At, B1); PG8_BAR; PG8_SCHED;
            PG8_LDA(At, 0, 1); PG8_STAGE(PG8_SB(0, 0), b2, voffB); PG8_STAGE(PG8_SB(0, 1), b2 + hstep, voffB); PG8_STAGE(PG8_SA(0, 0), a2, voffA);
            PG8_WAIT_V(8); PG8_WAIT_L(0); PG8_BAR; PG8_MMA(1, 0, At, B0); PG8_MMA(1, 1, At, B1); PG8_BAR; PG8_SCHED;
            PG8_LDB(B0, 1, 0); PG8_LDB(B1, 1, 1); PG8_SCHED; PG8_LDA(At, 1, 0); PG8_STAGE(PG8_SA(0, 1), a2 + hstep, voffA);
            PG8_WAIT_V(8); PG8_WAIT_L(0); PG8_BAR; PG8_MMA(0, 0, At, B0); PG8_MMA(0, 1, At, B1); PG8_BAR; PG8_SCHED;
            PG8_LDA(At, 1, 1); PG8_STAGE(PG8_SB(1, 0), b3, voffB); PG8_STAGE(PG8_SB(1, 1), b3 + hstep, voffB); PG8_STAGE(PG8_SA(1, 0), a3, voffA);
            PG8_WAIT_V(8); PG8_WAIT_L(0); PG8_BAR; PG8_MMA(1, 0, At, B0); PG8_MMA(1, 1, At, B1); PG8_BAR; PG8_SCHED;
            } else {
            PG8_LDB(B0, 0, 0); PG8_SCHED; PG8_LDA(At, 0, 0); PG8_STAGE(PG8_SA(1, 1), a1 + hstep, voffA);
            PG8_WAIT_L(8); PG8_BAR; PG8_WAIT_L(0); PG8_MMA(0, 0, At, B0); PG8_BAR; PG8_SCHED;
            PG8_LDB(B1, 0, 1); PG8_STAGE(PG8_SB(0, 0), b2, voffB);
            PG8_BAR; PG8_WAIT_L(0); PG8_MMA(0, 1, At, B1); PG8_BAR;
            PG8_LDA(At, 0, 1); PG8_STAGE(PG8_SA(0, 0), a2, voffA);
            PG8_BAR; PG8_WAIT_L(0); PG8_MMA(1, 0, At, B0); PG8_BAR; PG8_SCHED;
            PG8_STAGE(PG8_SB(0, 1), b2 + hstep, voffB);
            PG8_WAIT_V(6); PG8_BAR; PG8_MMA(1, 1, At, B1); PG8_BAR;
            PG8_LDB(B0, 1, 0); PG8_SCHED; PG8_LDA(At, 1, 0); PG8_STAGE(PG8_SA(0, 1), a2 + hstep, voffA);
            PG8_WAIT_L(8); PG8_BAR; PG8_WAIT_L(0); PG8_MMA(0, 0, At, B0); PG8_BAR; PG8_SCHED;
            PG8_LDB(B1, 1, 1); PG8_STAGE(PG8_SB(1, 0), b3, voffB);
            PG8_BAR; PG8_WAIT_L(0); PG8_MMA(0, 1, At, B1); PG8_BAR;
            PG8_LDA(At, 1, 1); PG8_STAGE(PG8_SA(1, 0), a3, voffA);
            PG8_BAR; PG8_WAIT_L(0); PG8_MMA(1, 0, At, B0); PG8_BAR; PG8_SCHED;
            PG8_STAGE(PG8_SB(1, 1), b3 + hstep, voffB);
            PG8_WAIT_V(6); PG8_BAR; PG8_MMA(1, 1, At, B1); PG8_BAR;
            }
        }
        if constexpr (ALIGN_EPI) { if (wr == 0) PG8_BAR; }
        if constexpr (!Epi::AFTER_DRAIN) { E(acc, cur, wr, wc, fr, fq); S.done(cur); }
        if (!has_next) break;
#pragma unroll
        for (int a = 0; a < 2; ++a)
#pragma unroll
            for (int b = 0; b < 2; ++b)
#pragma unroll
                for (int m = 0; m < 4; ++m)
#pragma unroll
                    for (int n = 0; n < 2; ++n) acc[a][b][m][n] = (f32x4){0.f, 0.f, 0.f, 0.f};
        cur = nxt; cA = nA; cB = nB; ++ui;
        if constexpr (ALIGN_EPI) { if (wr == 1) PG8_BAR; }
    }
    PG8_WAIT_V(0);
    if constexpr (!ALIGN_EPI) { if (wr == 0) PG8_BAR; }
    PG8_BAR;
    if constexpr (Epi::AFTER_DRAIN) { E.fused(acc, cur, wr, wc, fr, fq, lds, wid, lane); S.done(cur); }
#undef PG8_SA
#undef PG8_SB
#undef PG8_STAGE
#undef PG8_LDA
#undef PG8_LDB
#undef PG8_MMA
#undef PG8_WAIT_V
#undef PG8_WAIT_L
#undef PG8_BAR
#undef PG8_SCHED
}
}
#define LAS __attribute__((address_space(3)))
typedef unsigned short bf16_t;
typedef short bf16x8 __attribute__((ext_vector_type(8)));
typedef short s16x4 __attribute__((ext_vector_type(4)));
typedef float f32x4 __attribute__((ext_vector_type(4)));
typedef float f32x16 __attribute__((ext_vector_type(16)));
typedef unsigned u32x4 __attribute__((ext_vector_type(4)));
constexpr int BATCH = 2, SEQ = 8192, DM = 2048, M = BATCH * SEQ, DIN = 6656;
constexpr int C_RQ = 0, C_RK = 768, C_RV = 1536, C_RG = 2304, C_DQ = 3072, C_DK = 3584, C_DV = 4096, C_DG = 4608, C_LX = 5120, C_LG = 5888;
constexpr float EPS = 1e-6f;
constexpr size_t MiB = 1u << 20;
constexpr size_t WS_SSQ = 0, WS_RSTD = 128 * 1024, WS_BAR = 256 * 1024, WS_BAR_BYTES = 16384, WS_C8 = 320 * 1024;
constexpr size_t WS_COSR = 1 * MiB, WS_SINR = 5 * MiB, WS_COSD = 9 * MiB, WS_SIND = 11 * MiB, WS_LRUW = 13 * MiB;
constexpr size_t WS_HEND = 14 * MiB, WS_AEND = 14 * MiB + 512 * 1024, WS_CARRY = 15 * MiB;
constexpr size_t WS_WIN = 16 * MiB, WS_WOUT = 68 * MiB, WS_XB = 84 * MiB, WS_PROJ = 148 * MiB, WS_KV = 356 * MiB, WS_SP = 404 * MiB, WS_HL = 428 * MiB, WS_AC = 452 * MiB, WS_END = 476 * MiB;
constexpr size_t WS_MIXED = WS_XB, WS_Y = WS_PROJ;
constexpr int LDS_BYTES = 147456, LDS_BARST = 147200;

struct Params {
    const float* x; const int* pos; const float* pre_g; const float* w_in; const float* lq1; const float* lk1; const float* lq2; const float* lk2;
    const float* subln_g; const float* conv_w; const float* conv_b; const float* wa; const float* ba; const float* wx; const float* bx; const float* lru_lam;
    const float* w_out; const float* post_g; float* out; unsigned char* ws; int ph_lo, ph_hi;
};

#define MFMA32(a, b, c) __builtin_amdgcn_mfma_f32_32x32x16_bf16((a), (b), (c), 0, 0, 0)
__device__ __forceinline__ unsigned cvtpk(float lo, float hi) { return pg8::cvt_pk_bf16(lo, hi); }
__device__ __forceinline__ float bflo(unsigned w) { return __uint_as_float(w << 16); }
__device__ __forceinline__ float bfhi(unsigned w) { return __uint_as_float(w & 0xffff0000u); }
__device__ __forceinline__ int crow(int r, int hi) { return (r & 3) + 8 * (r >> 2) + 4 * hi; }
typedef short v4i16_t __attribute__((ext_vector_type(4)));
__device__ __forceinline__ s16x4 tr_read(const LAS unsigned char* p) { return __builtin_bit_cast(s16x4, __builtin_amdgcn_ds_read_tr16_b64_v4i16((LAS v4i16_t*)p)); }
__device__ __forceinline__ bf16x8 cat8(s16x4 lo, s16x4 hi) { return __builtin_shufflevector(lo, hi, 0, 1, 2, 3, 4, 5, 6, 7); }
__device__ __forceinline__ bf16x8 pack8(const f32x16& s, int b) { u32x4 w; w.x = cvtpk(s[b], s[b + 1]); w.y = cvtpk(s[b + 2], s[b + 3]); w.z = cvtpk(s[b + 4], s[b + 5]); w.w = cvtpk(s[b + 6], s[b + 7]); return __builtin_bit_cast(bf16x8, w); }
__device__ __forceinline__ float wave_sum(float v) {
#pragma unroll
    for (int o = 1; o < 64; o <<= 1) v += __shfl_xor(v, o);
    return v;
}
__device__ __forceinline__ float fexp2(float x) { return __builtin_amdgcn_exp2f(x); }
__device__ __forceinline__ float sigm(float x) { return 1.f / (1.f + __expf(-x)); }
__device__ __forceinline__ float silu(float x) { return x / (1.f + __expf(-x)); }
__device__ __forceinline__ float ret_log2g(int h) { return log2f(1.f - exp2f(-5.f - (float)h)); }

__device__ __forceinline__ int src_col_in(int n) {
    if (n < 1536) { const int cn = n & 127; return (n - cn) + (cn >> 1) + 64 * (cn & 1); }
    if (n >= 3072 && n < 4096) { const int cn = n & 63; return (n - cn) + (cn >> 1) + 32 * (cn & 1); }
    return n;
}
__device__ __forceinline__ void p0_transpose_item(const float* W, int K, int N, bf16_t* WT, const float* gk, bool perm, LAS float* scr, int item, int lane, bool late) {
    const int nblk = N / 32, kb = item / nblk, nb = item % nblk, k0 = 64 * kb, n0 = 32 * nb;
    const int krow = lane >> 3, part = lane & 7;
    int srcc = n0 + 4 * part, dst0 = 4 * part, dstep = 1;
    if (perm && (n0 < 1536 || (n0 >= 3072 && n0 < 4096))) {
        const int H = n0 < 1536 ? 128 : 64, cn0 = n0 & (H - 1), seg = part >> 2, j4 = part & 3;
        srcc = (n0 - cn0) + (cn0 >> 1) + 4 * j4 + seg * (H >> 1); dst0 = 8 * j4 + seg; dstep = 2;
    }
#pragma unroll
    for (int i = 0; i < 8; ++i) { const int kk = 8 * i + krow; f32x4 v = __builtin_nontemporal_load((const f32x4*)(W + (size_t)(k0 + kk) * N + srcc));     if (gk) v = v * gk[k0 + kk];
        LAS float* d = scr + kk * 33 + dst0; d[0] = v[0]; d[dstep] = v[1]; d[2 * dstep] = v[2]; d[3 * dstep] = v[3]; }
    asm volatile("s_waitcnt lgkmcnt(0)" ::: "memory");
    const int c = lane & 7;
#pragma unroll
    for (int j = 0; j < 4; ++j) { const int n = (lane >> 3) + 8 * j; const LAS float* s = scr + (8 * c) * 33 + n;
        u32x4 o; o.x = cvtpk(s[0 * 33], s[1 * 33]); o.y = cvtpk(s[2 * 33], s[3 * 33]); o.z = cvtpk(s[4 * 33], s[5 * 33]); o.w = cvtpk(s[6 * 33], s[7 * 33]);
        if (late) __builtin_nontemporal_store(o, (u32x4*)(WT + (size_t)(n0 + n) * K + k0 + 8 * c)); else *(u32x4*)(WT + (size_t)(n0 + n) * K + k0 + 8 * c) = o; }
    asm volatile("s_waitcnt lgkmcnt(0)" ::: "memory");
}
__device__ __forceinline__ void sincos_d(double a, float& s, float& c) {
    const double kq = rint(a * 0.63661977236758134308);
    double r = fma(-kq, 1.57079632679489655800e+00, a); r = fma(-kq, 6.12323399573676603587e-17, r);
    const int q = (int)((long long)kq & 3);
    const double r2 = r * r;
    const double sp = r * (1.0 + r2 * (-1.0 / 6.0 + r2 * (1.0 / 120.0 + r2 * (-1.0 / 5040.0 + r2 * (1.0 / 362880.0 + r2 * (-1.0 / 39916800.0 + r2 * (1.0 / 6227020800.0)))))));
    const double cp = 1.0 + r2 * (-0.5 + r2 * (1.0 / 24.0 + r2 * (-1.0 / 720.0 + r2 * (1.0 / 40320.0 + r2 * (-1.0 / 3628800.0 + r2 * (1.0 / 479001600.0))))));
    const double ss = (q & 1) ? cp : sp, cc = (q & 1) ? sp : cp;
    s = (float)((q & 2) ? -ss : ss); c = (float)(((q + 1) & 2) ? -cc : cc);
}
__device__ __forceinline__ void phase0(const Params& p, LAS unsigned char* L) {
    int tid = threadIdx.x; asm volatile("" : "+v"(tid)); const int lane = tid & 63, wave = tid >> 6;
    const int gw = blockIdx.x * 8 + wave, NGW = gridDim.x * 8, gt = blockIdx.x * 512 + tid, NT = gridDim.x * 512;
    unsigned char* ws = p.ws;
    LAS float* scr = (LAS float*)(L + wave * 16384);
    constexpr int I_IN = 32 * 208, I_OUT = 32 * 64, I_L = I_IN + I_OUT;
    for (int it = gw; it < 2 * I_L; it += NGW) {
        const int layer = it / I_L, r = it - layer * I_L;
        if (r < I_IN) p0_transpose_item(p.w_in + (size_t)layer * 2048 * DIN, 2048, DIN, (bf16_t*)(ws + WS_WIN) + (size_t)layer * DIN * 2048, p.pre_g + layer * 2048, true, scr, r, lane, layer != 0);
        else p0_transpose_item(p.w_out + (size_t)layer * 2048 * 2048, 2048, 2048, (bf16_t*)(ws + WS_WOUT) + (size_t)layer * 2048 * 2048, nullptr, false, scr, r - I_IN, lane, true);
    }
    float* rstd = (float*)(ws + WS_RSTD); bf16_t* XB = (bf16_t*)(ws + WS_XB);
    for (int m = gw; m < M; m += NGW) {
        const float* xr = p.x + (size_t)m * DM; f32x4 v[8]; float s = 0.f;
#pragma unroll
        for (int j = 0; j < 4; ++j) { v[2 * j] = __builtin_nontemporal_load((const f32x4*)(xr + j * 512 + lane * 8)); v[2 * j + 1] = __builtin_nontemporal_load((const f32x4*)(xr + j * 512 + lane * 8 + 4));
            const f32x4 a = v[2 * j], b = v[2 * j + 1]; s += (a[0] * a[0] + a[1] * a[1]) + (a[2] * a[2] + a[3] * a[3]) + (b[0] * b[0] + b[1] * b[1]) + (b[2] * b[2] + b[3] * b[3]); }
        s = wave_sum(s);
        if (lane == 0) rstd[m] = 1.f / sqrtf(s * (1.f / DM) + EPS);
#pragma unroll
        for (int j = 0; j < 4; ++j) { const f32x4 a = v[2 * j], b = v[2 * j + 1]; u32x4 w; w.x = cvtpk(a[0], a[1]); w.y = cvtpk(a[2], a[3]); w.z = cvtpk(b[0], b[1]); w.w = cvtpk(b[2], b[3]);
            *(u32x4*)(XB + (size_t)m * DM + j * 512 + lane * 8) = w; }
    }
    float* cosR = (float*)(ws + WS_COSR); float* sinR = (float*)(ws + WS_SINR); float* cosD = (float*)(ws + WS_COSD); float* sinD = (float*)(ws + WS_SIND);
    for (int e = gt; e < M * 96; e += NT) {
        const int m = e / 96, f = e - m * 96; const double pos = (double)p.pos[m];
        float s, c;
        if (f < 64) { const double inv = exp(-((double)f / 63.0) * 9.210340371976184); sincos_d(pos * inv, s, c); cosR[(size_t)m * 64 + f] = c; sinR[(size_t)m * 64 + f] = s; }
        else { const int i = f - 64; const double inv = exp(-((double)(2 * i) / 64.0) * 9.210340371976184); sincos_d(pos * inv, s, c); cosD[(size_t)m * 32 + i] = c; sinD[(size_t)m * 32 + i] = s; }
    }
    float* ssq = (float*)(ws + WS_SSQ);
    for (int e = gt; e < 2 * M; e += NT) ssq[e] = 0.f;
    float* C8 = (float*)(ws + WS_C8);
    for (int e = gt; e < 2 * 768; e += NT) C8[e] = -8.f * log1pf(expf(-p.lru_lam[e]));
    bf16_t* LW = (bf16_t*)(ws + WS_LRUW);
    for (int e = gt; e < 2 * 2 * 8 * 96 * 96; e += NT) {
        const int k = e % 96, j = (e / 96) % 96, n = (e / 9216) % 8, gate = (e / 73728) % 2, l = e / 147456;
        const float v = (gate ? p.wx : p.wa)[(size_t)((l * 8 + n) * 96 + k) * 96 + j];
        LW[e] = (bf16_t)(cvtpk(v, 0.f) & 0xffffu);
    }
}
constexpr int AT_KP = 272, AT_VP = 320, AT_KB = 64 * AT_KP, AT_VB = 64 * AT_VP, AT_KOFF = 0, AT_VOFF = 2 * AT_KB, AT_XOFF = 0, AT_EOFF = 65536, E_PITCH = 132;
__device__ __forceinline__ float max3f(float a, float b, float c) { float r; asm("v_max3_f32 %0, %1, %2, %3" : "=v"(r) : "v"(a), "v"(b), "v"(c)); return r; }
__device__ __forceinline__ float max2f(float a, float b) { float r; asm("v_max_f32_e32 %0, %1, %2" : "=v"(r) : "v"(a), "v"(b)); return r; }
__device__ __forceinline__ float xhalf_max(float m) { auto rr = __builtin_amdgcn_permlane32_swap(__float_as_uint(m), __float_as_uint(m), false, false); return max2f(__uint_as_float(rr[0]), __uint_as_float(rr[1])); }
__device__ __forceinline__ float xhalf_sum(float m) { auto rr = __builtin_amdgcn_permlane32_swap(__float_as_uint(m), __float_as_uint(m), false, false); return __uint_as_float(rr[0]) + __uint_as_float(rr[1]); }
__device__ __forceinline__ void attn_item(LAS unsigned char* L, const bf16_t* PROJ, bf16_t* MIXED, const float* subln, int b, int h, int qb, float lam, float one_m_li) {
    int tid = threadIdx.x; asm volatile("" : "+v"(tid)); const int lane = tid & 63, wid = __builtin_amdgcn_readfirstlane(tid >> 6), l31 = lane & 31, hi = lane >> 5;
    const int c = wid >> 2, rb = wid & 3;
    const int q0 = qb * 128; const size_t rowbase = (size_t)b * SEQ;
    bf16x8 qf[4];
    { const bf16_t* qp = PROJ + (rowbase + q0 + 32 * rb + l31) * DIN + C_DQ + h * 128 + c * 64 + 8 * hi;
#pragma unroll
      for (int s = 0; s < 4; ++s) qf[s] = *(const bf16x8*)(qp + 16 * s); }
    f32x16 o[4];
#pragma unroll
    for (int e = 0; e < 4; ++e)
#pragma unroll
        for (int r = 0; r < 16; ++r) o[e][r] = 0.f;
    float m_run = 0.f, l_run = 0.f;
    const int nt = (q0 + 128) / 64;
    const bf16_t* kg = PROJ + (rowbase + (tid >> 4)) * DIN + C_DK + h * 128 + (tid & 15) * 8;
    const bf16_t* vg = kg + (C_DV - C_DK);
    const int st_k = (tid >> 4) * AT_KP + (tid & 15) * 16, st_v = (tid >> 4) * AT_VP + (tid & 15) * 16;
    u32x4 kr[2], vr[2];
#define AT_LOAD(t) { _Pragma("unroll") for (int i_ = 0; i_ < 2; ++i_) { const size_t go_ = (size_t)((t) * 64 + 32 * i_) * DIN; kr[i_] = *(const u32x4*)(kg + go_); vr[i_] = *(const u32x4*)(vg + go_); } }
#define AT_STORE(kbf, vsl) { _Pragma("unroll") for (int i_ = 0; i_ < 2; ++i_) { *(LAS u32x4*)(L + AT_KOFF + (kbf) * AT_KB + st_k + 32 * i_ * AT_KP) = kr[i_]; *(LAS u32x4*)(L + AT_VOFF + (vsl) * AT_VB + st_v + 32 * i_ * AT_VP) = vr[i_]; } }
    AT_LOAD(0); AT_STORE(0, 0); __syncthreads();
    const int g = lane >> 4, tq = (lane & 15) >> 2, tp = lane & 3;
    const int vlane = (4 * hi + tq) * AT_VP + (16 * (g & 1) + 4 * tp) * 2;
    const int klane = l31 * AT_KP + (c * 64 + 8 * hi) * 2;
    const int qi = q0 + 32 * rb + l31;
    bf16x8 pb[4];
    f32x16 s0, s1;
#define AT_QK(t_) { const int k0 = (t_) * 64; \
        const LAS unsigned char* kb = L + AT_KOFF + ((t_) & 1) * AT_KB + klane; bf16x8 ka[4], kc[4]; \
        _Pragma("unroll") for (int s = 0; s < 4; ++s) { ka[s] = *(const LAS bf16x8*)(kb + s * 32); kc[s] = *(const LAS bf16x8*)(kb + 32 * AT_KP + s * 32); } \
        _Pragma("unroll") for (int r = 0; r < 16; ++r) { s0[r] = 0.f; s1[r] = 0.f; } \
        _Pragma("unroll") for (int s = 0; s < 4; ++s) { s0 = MFMA32(ka[s], qf[s], s0); s1 = MFMA32(kc[s], qf[s], s1); } \
        if (k0 + 63 > q0 + 32 * rb) { _Pragma("unroll") for (int r = 0; r < 16; ++r) { const int key = k0 + crow(r, hi); if (key > qi) s0[r] = -INFINITY; if (key + 32 > qi) s1[r] = -INFINITY; } } \
        asm volatile("s_nop 15\n\ts_nop 7" : "+v"(s0), "+v"(s1));     \
        { float ma = max3f(s0[0], s0[1], s1[0]), mb = max3f(s0[2], s0[3], s1[1]); ma = max3f(ma, s1[2], s1[3]); \
          _Pragma("unroll") for (int r = 4; r < 16; r += 4) { ma = max3f(ma, s0[r], s0[r + 1]); mb = max3f(mb, s0[r + 2], s0[r + 3]); ma = max3f(ma, s1[r], s1[r + 1]); mb = max3f(mb, s1[r + 2], s1[r + 3]); } \
          mx = xhalf_max(max2f(ma, mb)); } }
#define AT_LDV(dst, ks_) { _Pragma("unroll") for (int e = 0; e < 4; ++e) { dst[2 * e] = tr_read(vb + (16 * (ks_)) * AT_VP + 64 * e); dst[2 * e + 1] = tr_read(vb + (16 * (ks_) + 8) * AT_VP + 64 * e); } }
#define AT_MMV(src, ks_) { _Pragma("unroll") for (int e = 0; e < 4; ++e) o[e] = MFMA32(cat8(src[2 * e], src[2 * e + 1]), pb[ks_], o[e]); }
#define AT_EXP(S, lo_) { _Pragma("unroll") for (int r = (lo_); r < (lo_) + 8; ++r) { S[r] = fexp2(S[r] - m_new); rs += S[r]; } }
    { float mx; AT_QK(0); m_run = mx; const float m_new = mx; float rs = 0.f; AT_EXP(s0, 0); AT_EXP(s0, 8); AT_EXP(s1, 0); AT_EXP(s1, 8); l_run = rs;
      pb[0] = pack8(s0, 0); pb[1] = pack8(s0, 8); pb[2] = pack8(s1, 0); pb[3] = pack8(s1, 8); }
    int vs = 1, vsp = 0;
    AT_LOAD(1); AT_STORE(1, 1); __syncthreads();
    u32x4 kr2[2], vr2[2];
#define AT_LOADS(KR, VR, t) { _Pragma("unroll") for (int i_ = 0; i_ < 2; ++i_) { const size_t go_ = (size_t)((t) * 64 + 32 * i_) * DIN; KR[i_] = *(const u32x4*)(kg + go_); VR[i_] = *(const u32x4*)(vg + go_); } }
#define AT_STORES(KR, VR, kbf, vsl) { _Pragma("unroll") for (int i_ = 0; i_ < 2; ++i_) { *(LAS u32x4*)(L + AT_KOFF + (kbf) * AT_KB + st_k + 32 * i_ * AT_KP) = KR[i_]; *(LAS u32x4*)(L + AT_VOFF + (vsl) * AT_VB + st_v + 32 * i_ * AT_VP) = VR[i_]; } }
#define AT_ITER(t_, KS, VS, KL, VL) { \
        const int vsn = vs == 2 ? 0 : vs + 1; \
        if ((t_) + 2 < nt) AT_LOADS(KL, VL, (t_) + 2); \
        const LAS unsigned char* vb = L + AT_VOFF + vsp * AT_VB + vlane; s16x4 va[8], vn[8]; \
        AT_LDV(va, 0); AT_LDV(vn, 1);     \
        float mx; AT_QK(t_); \
        const bool need = __any(mx > m_run); \
        const float m_new = max2f(m_run, mx); \
        float rs = 0.f; \
        AT_MMV(va, 0); AT_EXP(s0, 0); AT_LDV(va, 2); \
        AT_MMV(vn, 1); AT_EXP(s0, 8); AT_LDV(vn, 3); \
        AT_MMV(va, 2); AT_EXP(s1, 0); \
        AT_MMV(vn, 3); AT_EXP(s1, 8); \
        bf16x8 pn[4]; pn[0] = pack8(s0, 0); pn[1] = pack8(s0, 8); pn[2] = pack8(s1, 0); pn[3] = pack8(s1, 8); \
        asm volatile("" : "+v"(pn[0]), "+v"(pn[1]), "+v"(pn[2]), "+v"(pn[3]), "+v"(rs)); \
        if (need) { const float alpha = fexp2(m_run - m_new); l_run *= alpha; \
            _Pragma("unroll") for (int e = 0; e < 4; ++e) _Pragma("unroll") for (int r = 0; r < 16; ++r) o[e][r] *= alpha; } \
        m_run = m_new; l_run += rs; \
        pb[0] = pn[0]; pb[1] = pn[1]; pb[2] = pn[2]; pb[3] = pn[3]; \
        if ((t_) + 1 < nt) AT_STORES(KS, VS, ((t_) + 1) & 1, vsn); \
        __syncthreads(); \
        vsp = vs; vs = vsn; }
    if (2 < nt) AT_LOADS(kr, vr, 2);
    for (int t = 1; t < nt; t += 2) {
        AT_ITER(t, kr, vr, kr2, vr2);
        if (t + 1 < nt) { AT_ITER(t + 1, kr2, vr2, kr, vr); }
    }
#undef AT_LOADS
#undef AT_STORES
#undef AT_ITER
    { const LAS unsigned char* vb = L + AT_VOFF + vsp * AT_VB + vlane; s16x4 va[8], vn[8];
      AT_LDV(va, 0); AT_LDV(vn, 1); AT_MMV(va, 0); AT_LDV(va, 2); AT_MMV(vn, 1); AT_LDV(vn, 3); AT_MMV(va, 2); AT_MMV(vn, 3); }
    __syncthreads();
#undef AT_LOAD
#undef AT_STORE
#undef AT_QK
#undef AT_LDV
#undef AT_MMV
#undef AT_EXP
    u32x4 gwv[4];
    { const bf16_t* gp_ = PROJ + (rowbase + q0 + (tid >> 2)) * DIN + C_DG + h * 128 + 32 * (tid & 3);
#pragma unroll
      for (int j = 0; j < 4; ++j) gwv[j] = *(const u32x4*)(gp_ + 8 * j); }
    l_run = xhalf_sum(l_run);
    const float sc = (c == 0 ? 1.f : -lam) / l_run;
#pragma unroll
    for (int e = 0; e < 4; ++e)
#pragma unroll
        for (int r = 0; r < 16; ++r) o[e][r] *= sc;
    LAS float* X = (LAS float*)(L + AT_XOFF); LAS float* E = (LAS float*)(L + AT_EOFF);
    if (c == 1) {
#pragma unroll
        for (int e = 0; e < 4; ++e)
#pragma unroll
            for (int r = 0; r < 16; ++r) X[((e * 16 + r) * 4 + rb) * 64 + lane] = o[e][r];
    }
    __syncthreads();
    if (c == 0) {
#pragma unroll
        for (int e = 0; e < 4; ++e)
#pragma unroll
            for (int r = 0; r < 16; ++r) o[e][r] += X[((e * 16 + r) * 4 + rb) * 64 + lane];
#pragma unroll
        for (int e = 0; e < 4; ++e)
#pragma unroll
            for (int r4 = 0; r4 < 4; ++r4) *(LAS f32x4*)(E + (32 * rb + l31) * E_PITCH + 32 * e + 8 * r4 + 4 * hi) = (f32x4){o[e][4 * r4], o[e][4 * r4 + 1], o[e][4 * r4 + 2], o[e][4 * r4 + 3]};
    }
    __syncthreads();
    { const int row = tid >> 2, qtr = tid & 3; const LAS float* er = E + row * E_PITCH + 32 * qtr; f32x4 v[8]; float ss = 0.f;
#pragma unroll
      for (int j = 0; j < 8; ++j) { v[j] = *(const LAS f32x4*)(er + 4 * j); ss += (v[j][0] * v[j][0] + v[j][1] * v[j][1]) + (v[j][2] * v[j][2] + v[j][3] * v[j][3]); }
      ss += __shfl_xor(ss, 1); ss += __shfl_xor(ss, 2);
      const float rstd = one_m_li / sqrtf(ss * (1.f / 128.f) + EPS);
      const size_t m = rowbase + q0 + row; const bf16_t* gp = PROJ + m * DIN + C_DG + h * 128 + 32 * qtr; bf16_t* op = MIXED + m * 2048 + 768 + h * 128 + 32 * qtr; const float* sg = subln + 32 * qtr;
#pragma unroll
      for (int j = 0; j < 4; ++j) { const u32x4 gw = gwv[j]; const f32x4 a = v[2 * j], bq = v[2 * j + 1]; const f32x4 g0 = *(const f32x4*)(sg + 8 * j), g1 = *(const f32x4*)(sg + 8 * j + 4);
          u32x4 w; w.x = cvtpk(a[0] * rstd * g0[0] * silu(bflo(gw.x)), a[1] * rstd * g0[1] * silu(bfhi(gw.x))); w.y = cvtpk(a[2] * rstd * g0[2] * silu(bflo(gw.y)), a[3] * rstd * g0[3] * silu(bfhi(gw.y)));
          w.z = cvtpk(bq[0] * rstd * g1[0] * silu(bflo(gw.z)), bq[1] * rstd * g1[1] * silu(bfhi(gw.z))); w.w = cvtpk(bq[2] * rstd * g1[2] * silu(bflo(gw.w)), bq[3] * rstd * g1[3] * silu(bfhi(gw.w)));
          *(u32x4*)(op + 8 * j) = w; }
    }
    __syncthreads();
}

constexpr int RT_P = 320, RK_P = 272;
__device__ __forceinline__ void ret_kv_phase(LAS unsigned char* L, const bf16_t* PROJ, float* KV, int bid, int G) {
    int tid = threadIdx.x; asm volatile("" : "+v"(tid)); const int lane = tid & 63, wid = __builtin_amdgcn_readfirstlane(tid >> 6), l31 = lane & 31, hi = lane >> 5;
    LAS unsigned char* Kb = L; LAS unsigned char* Vb = L + 128 * RT_P;
    u32x4 rk[4], rv[4];
#define RK_LOAD(it_) { const int h_ = (it_) % 6, n_ = ((it_) / 6) % 64, b_ = (it_) / 384; const size_t rb_ = (size_t)b_ * SEQ + (size_t)n_ * 128; \
        _Pragma("unroll") for (int i_ = 0; i_ < 4; ++i_) { const int id = tid + 512 * i_, row = id >> 4, ch = id & 15; const bf16_t* src = PROJ + (rb_ + row) * DIN + h_ * 128 + ch * 8; \
            rk[i_] = *(const u32x4*)(src + C_RK); rv[i_] = *(const u32x4*)(src + C_RV); } }
    int it = bid;
    if (it < 768) RK_LOAD(it);
    for (; it < 768; it += G) {
        const int h = it % 6, n = (it / 6) % 64, b = it / 384;
        const float log2g = ret_log2g(h);
#pragma unroll
        for (int i = 0; i < 4; ++i) { const int id = tid + 512 * i, row = id >> 4, ch = id & 15;
            const u32x4 kv_ = rk[i];
            const float w = fexp2((float)(127 - row) * log2g);
            u32x4 ks; ks.x = cvtpk(bflo(kv_.x) * w, bfhi(kv_.x) * w); ks.y = cvtpk(bflo(kv_.y) * w, bfhi(kv_.y) * w); ks.z = cvtpk(bflo(kv_.z) * w, bfhi(kv_.z) * w); ks.w = cvtpk(bflo(kv_.w) * w, bfhi(kv_.w) * w);
            *(LAS u32x4*)(Kb + row * RT_P + ch * 16) = ks; *(LAS u32x4*)(Vb + row * RT_P + ch * 16) = rv[i]; }
        __syncthreads();
        if (it + G < 768) RK_LOAD(it + G);
        const int eb = wid >> 1, db0 = 2 * (wid & 1);
        const int g = lane >> 4, tq = (lane & 15) >> 2, tp = lane & 3;
        const int lanepart = (8 * hi + tq) * RT_P + (16 * (g & 1) + 4 * tp) * 2;
        f32x16 acc[2];
#pragma unroll
        for (int j = 0; j < 2; ++j)
#pragma unroll
            for (int r = 0; r < 16; ++r) acc[j][r] = 0.f;
#pragma unroll
        for (int s = 0; s < 8; ++s) {
            const LAS unsigned char* va = Vb + (16 * s) * RT_P + lanepart + 64 * eb;
            const bf16x8 A = cat8(tr_read(va), tr_read(va + 4 * RT_P));
#pragma unroll
            for (int j = 0; j < 2; ++j) { const LAS unsigned char* ka = Kb + (16 * s) * RT_P + lanepart + 64 * (db0 + j); const bf16x8 B = cat8(tr_read(ka), tr_read(ka + 4 * RT_P)); acc[j] = MFMA32(A, B, acc[j]); }
        }
        float* dst = KV + ((size_t)((b * 6 + h) * 64 + n)) * 16384;
#pragma unroll
        for (int j = 0; j < 2; ++j)
#pragma unroll
            for (int r = 0; r < 16; ++r) dst[(32 * eb + crow(r, hi)) * 128 + 32 * (db0 + j) + l31] = acc[j][r];
        __syncthreads();
    }
#undef RK_LOAD
}
__device__ __forceinline__ void ret_out_phase(LAS unsigned char* L, const bf16_t* PROJ, const bf16_t* SP, bf16_t* MIXED, int bid, int G) {
    int tid = threadIdx.x; asm volatile("" : "+v"(tid)); const int lane = tid & 63, wid = __builtin_amdgcn_readfirstlane(tid >> 6), l31 = lane & 31, hi = lane >> 5;
    LAS unsigned char* Kb = L; LAS unsigned char* Sb = L + 128 * RK_P; LAS unsigned char* Vb = L + 2 * 128 * RK_P; LAS unsigned char* Qb = Vb + 128 * RT_P;
    u32x4 rk[4], rv[4], rs_[4], rq[4];
#define RO_LOAD(it_) { const int h_ = (it_) % 6, n_ = ((it_) / 6) % 64, b_ = (it_) / 384; const size_t rb_ = (size_t)b_ * SEQ + (size_t)n_ * 128; \
        const bf16_t* sp_ = SP + ((size_t)((b_ * 6 + h_) * 64 + n_)) * 16384; \
        _Pragma("unroll") for (int i_ = 0; i_ < 4; ++i_) { const int id = tid + 512 * i_, row = id >> 4, ch = id & 15; const bf16_t* src = PROJ + (rb_ + row) * DIN + h_ * 128 + ch * 8; \
            rk[i_] = *(const u32x4*)(src + C_RK); rv[i_] = *(const u32x4*)(src + C_RV); rq[i_] = *(const u32x4*)(src + C_RQ); rs_[i_] = *(const u32x4*)(sp_ + row * 128 + ch * 8); } }
    int it = bid;
    if (it < 768) RO_LOAD(it);
    for (; it < 768; it += G) {
        const int h = it % 6, n = (it / 6) % 64, b = it / 384;
        const float log2g = ret_log2g(h);
        const size_t rowbase = (size_t)b * SEQ + (size_t)n * 128;
#pragma unroll
        for (int i = 0; i < 4; ++i) { const int id = tid + 512 * i, row = id >> 4, ch = id & 15;
            *(LAS u32x4*)(Kb + row * RK_P + ch * 16) = rk[i]; *(LAS u32x4*)(Vb + row * RT_P + ch * 16) = rv[i];
            *(LAS u32x4*)(Sb + row * RK_P + ch * 16) = rs_[i]; *(LAS u32x4*)(Qb + row * RK_P + ch * 16) = rq[i]; }
        __syncthreads();
        if (it + G < 768) RO_LOAD(it + G);
        u32x4 gwv[4];
        { const int row = tid >> 2, qtr = tid & 3; const bf16_t* gp = PROJ + (rowbase + row) * DIN + C_RG + h * 128 + 32 * qtr;
#pragma unroll
          for (int j = 0; j < 4; ++j) gwv[j] = *(const u32x4*)(gp + 8 * j); }
        const int ib = wid & 3, eh = wid >> 2;
        bf16x8 qf[8];
#pragma unroll
        for (int s = 0; s < 8; ++s) qf[s] = *(const LAS bf16x8*)(Qb + (32 * ib + l31) * RK_P + (16 * s + 8 * hi) * 2);
        f32x16 acc[2];
#pragma unroll
        for (int j = 0; j < 2; ++j)
#pragma unroll
            for (int r = 0; r < 16; ++r) acc[j][r] = 0.f;
#pragma unroll
        for (int s = 0; s < 8; ++s)
#pragma unroll
            for (int j = 0; j < 2; ++j) { const bf16x8 A = *(const LAS bf16x8*)(Sb + (32 * (2 * eh + j) + l31) * RK_P + (16 * s + 8 * hi) * 2); acc[j] = MFMA32(A, qf[s], acc[j]); }
        const int iloc = 32 * ib + l31;
        { const float qw = fexp2((float)(iloc + 1) * log2g);
#pragma unroll
          for (int j = 0; j < 2; ++j)
#pragma unroll
              for (int r = 0; r < 16; ++r) acc[j][r] *= qw; }
        const int g = lane >> 4, tq = (lane & 15) >> 2, tp = lane & 3;
        const int vlane = (4 * hi + tq) * RT_P + (16 * (g & 1) + 4 * tp) * 2;
        for (int jb = 0; jb <= ib; ++jb) {
            f32x16 S;
#pragma unroll
            for (int r = 0; r < 16; ++r) S[r] = 0.f;
#pragma unroll
            for (int s = 0; s < 8; ++s) { const bf16x8 A = *(const LAS bf16x8*)(Kb + (32 * jb + l31) * RK_P + (16 * s + 8 * hi) * 2); S = MFMA32(A, qf[s], S); }
#pragma unroll
            for (int r = 0; r < 16; ++r) { const int d = iloc - (32 * jb + crow(r, hi)); S[r] = d >= 0 ? S[r] * fexp2((float)d * log2g) : 0.f; }
            bf16x8 pb[2]; pb[0] = pack8(S, 0); pb[1] = pack8(S, 8);
#pragma unroll
            for (int t2 = 0; t2 < 2; ++t2)
#pragma unroll
                for (int j = 0; j < 2; ++j) { const LAS unsigned char* va = Vb + (32 * jb + 16 * t2) * RT_P + vlane + 64 * (2 * eh + j); acc[j] = MFMA32(cat8(tr_read(va), tr_read(va + 8 * RT_P)), pb[t2], acc[j]); }
        }
        __syncthreads();
        LAS float* E = (LAS float*)L;
#pragma unroll
        for (int j = 0; j < 2; ++j)
#pragma unroll
            for (int r4 = 0; r4 < 4; ++r4) *(LAS f32x4*)(E + (32 * ib + l31) * E_PITCH + 32 * (2 * eh + j) + 8 * r4 + 4 * hi) = (f32x4){acc[j][4 * r4], acc[j][4 * r4 + 1], acc[j][4 * r4 + 2], acc[j][4 * r4 + 3]};
        __syncthreads();
        { const int row = tid >> 2, qtr = tid & 3; const LAS float* er = E + row * E_PITCH + 32 * qtr; f32x4 v[8]; float ss = 0.f;
#pragma unroll
          for (int j = 0; j < 8; ++j) { v[j] = *(const LAS f32x4*)(er + 4 * j); ss += (v[j][0] * v[j][0] + v[j][1] * v[j][1]) + (v[j][2] * v[j][2] + v[j][3] * v[j][3]); }
          ss += __shfl_xor(ss, 1); ss += __shfl_xor(ss, 2);
          const float rstd = 1.f / sqrtf(ss * (1.f / 128.f) + EPS);
          bf16_t* op = MIXED + (rowbase + row) * 2048 + h * 128 + 32 * qtr;
#pragma unroll
          for (int j = 0; j < 4; ++j) { const u32x4 gw = gwv[j]; const f32x4 a = v[2 * j], bq = v[2 * j + 1];
              u32x4 w; w.x = cvtpk(a[0] * rstd * silu(bflo(gw.x)), a[1] * rstd * silu(bfhi(gw.x))); w.y = cvtpk(a[2] * rstd * silu(bflo(gw.y)), a[3] * rstd * silu(bfhi(gw.y)));
              w.z = cvtpk(bq[0] * rstd * silu(bflo(gw.z)), bq[1] * rstd * silu(bfhi(gw.z))); w.w = cvtpk(bq[2] * rstd * silu(bflo(gw.w)), bq[3] * rstd * silu(bfhi(gw.w)));
              *(u32x4*)(op + 8 * j) = w; }
        }
        __syncthreads();
    }
#undef RO_LOAD
}
constexpr int LR_XC = 0, LR_XCB = 49664, LR_GA = 76288, LR_LX = 76288, LR_XP = 97, LR_BP = 208;
constexpr int LR_CST = 125952;
__device__ __forceinline__ void lru_phase(LAS unsigned char* L, const Params& p, int layer, const bf16_t* PROJ, const bf16_t* LW, const float* C8, unsigned* HA, float* HEND, float* AEND, int bid, int G) {
    int tid = threadIdx.x; asm volatile("" : "+v"(tid)); const int lane = tid & 63, wid = __builtin_amdgcn_readfirstlane(tid >> 6), l31 = lane & 31, hi = lane >> 5;
    LAS float* XC = (LAS float*)(L + LR_XC); LAS unsigned char* XCB = L + LR_XCB; LAS float* GA = (LAS float*)(L + LR_GA); LAS unsigned char* LX = L + LR_LX; LAS float* CST = (LAS float*)(L + LR_CST);
    u32x4 lxr[4];
#define LRU_LOAD(it_) { const int jb_ = (it_) & 7, n_ = ((it_) >> 3) & 63, b_ = (it_) >> 9; const size_t rb_ = (size_t)b_ * SEQ + (size_t)n_ * 128; \
        _Pragma("unroll") for (int i_ = 0; i_ < 4; ++i_) { const int id = tid + 512 * i_; const int row = id / 12, ch = id - row * 12; lxr[i_] = (u32x4){0u, 0u, 0u, 0u}; \
            if (id < 131 * 12 && (n_ > 0 || row >= 3)) lxr[i_] = *(const u32x4*)(PROJ + (rb_ + row - 3) * DIN + C_LX + 96 * jb_ + 8 * ch); } }
    int it = bid;
    if (it < 1024) LRU_LOAD(it);
    for (; it < 1024; it += G) {
        const int jb = it & 7, n = (it >> 3) & 63, b = it >> 9;
        const size_t rowbase = (size_t)b * SEQ + (size_t)n * 128;
#pragma unroll
        for (int i = 0; i < 4; ++i) { const int id = tid + 512 * i; const int row = id / 12, ch = id - row * 12; if (id < 131 * 12) *(LAS u32x4*)(LX + row * 192 + ch * 16) = lxr[i]; }
        for (int e = tid; e < 768; e += 512) { const int a = e / 96, c = e - a * 96; float v;
            if (a == 0) v = p.ba[layer * 768 + 96 * jb + c]; else if (a == 1) v = p.bx[layer * 768 + 96 * jb + c]; else if (a == 2) v = C8[layer * 768 + 96 * jb + c];
            else if (a < 7) v = p.conv_w[(size_t)layer * 4 * 768 + (a - 3) * 768 + 96 * jb + c]; else v = p.conv_b[layer * 768 + 96 * jb + c];
            CST[e] = v; }
        const int tb = wid & 3, half = wid >> 2; const int cb0 = half == 0 ? 0 : 2, cb1 = half == 0 ? 2 : 3;
        const bf16_t* WA = LW + ((size_t)((layer * 2 + 0) * 8 + jb)) * 9216; const bf16_t* WX = LW + ((size_t)((layer * 2 + 1) * 8 + jb)) * 9216;
        bf16x8 fa[6], fx[6];
#pragma unroll
        for (int s = 0; s < 6; ++s) { fa[s] = *(const bf16x8*)(WA + (32 * cb0 + l31) * 96 + 16 * s + 8 * hi); fx[s] = *(const bf16x8*)(WX + (32 * cb0 + l31) * 96 + 16 * s + 8 * hi); }
        __syncthreads();
        if (it + G < 1024) LRU_LOAD(it + G);
        if (tid < 480) { const int c = tid % 96, grp = tid / 96; const int t0 = grp * 26, t1 = t0 + 26 < 128 ? t0 + 26 : 128;
            const float w0 = CST[3 * 96 + c], w1 = CST[4 * 96 + c], w2 = CST[5 * 96 + c], w3 = CST[6 * 96 + c], bs = CST[7 * 96 + c];
            const LAS unsigned short* lx = (const LAS unsigned short*)(LX + c * 2);
            float x0 = __uint_as_float((unsigned)lx[(t0 + 0) * 96] << 16), x1 = __uint_as_float((unsigned)lx[(t0 + 1) * 96] << 16), x2 = __uint_as_float((unsigned)lx[(t0 + 2) * 96] << 16);
            for (int t = t0; t < t1; ++t) { const float x3 = __uint_as_float((unsigned)lx[(t + 3) * 96] << 16);
                const float acc = bs + x0 * w0 + x1 * w1 + x2 * w2 + x3 * w3;
                XC[t * LR_XP + c] = acc; *(LAS unsigned short*)(XCB + t * LR_BP + c * 2) = (unsigned short)(cvtpk(acc, 0.f) & 0xffffu);
                x0 = x1; x1 = x2; x2 = x3; } }
        __syncthreads();
        { const int tok = 32 * tb + l31;
          for (int cbk = cb0; cbk < cb1; ++cbk) {
              f32x16 aR, aI;
#pragma unroll
              for (int r = 0; r < 16; ++r) { aR[r] = 0.f; aI[r] = 0.f; }
              if (cbk != cb0) {
#pragma unroll
                  for (int s = 0; s < 6; ++s) { fa[s] = *(const bf16x8*)(WA + (32 * cbk + l31) * 96 + 16 * s + 8 * hi); fx[s] = *(const bf16x8*)(WX + (32 * cbk + l31) * 96 + 16 * s + 8 * hi); }
              }
#pragma unroll
              for (int s = 0; s < 6; ++s) { const bf16x8 B = *(const LAS bf16x8*)(XCB + tok * LR_BP + (16 * s + 8 * hi) * 2); aR = MFMA32(fa[s], B, aR); aI = MFMA32(fx[s], B, aI); }
#pragma unroll
              for (int r = 0; r < 16; ++r) { const int cc = 32 * cbk + crow(r, hi);
                  const float rr = sigm(aR[r] + CST[cc]), ii = sigm(aI[r] + CST[96 + cc]);
                  const float log_a = rr * CST[192 + cc]; const float a = __expf(log_a); const float x2 = 2.f * log_a;
                  const float m1s = -x2 * (1.f + x2 * (0.5f + x2 * (0.16666667f + x2 * (0.041666668f + x2 * 0.008333334f))));
                  const float m1 = x2 < -0.25f ? 1.f - a * a : m1s;
                  const float mult = __builtin_amdgcn_sqrtf(m1);
                  const float xcv = XC[tok * LR_XP + cc];
                  GA[tok * LR_XP + cc] = a; XC[tok * LR_XP + cc] = mult * (ii * xcv); }
          }
        }
        __syncthreads();
        LAS float* SEGA = (LAS float*)XCB; LAS float* SEGH = SEGA + 4 * 96;
        const int sc_c = tid % 96, seg = tid / 96;
        float av[32], bv[32];
        if (tid < 384) {
#pragma unroll
            for (int t = 0; t < 32; ++t) { av[t] = GA[(32 * seg + t) * LR_XP + sc_c]; bv[t] = XC[(32 * seg + t) * LR_XP + sc_c]; }
            float A = 1.f, H = 0.f;
#pragma unroll
            for (int t = 0; t < 32; ++t) { H = av[t] * H + bv[t]; A *= av[t]; av[t] = A; bv[t] = H; }
            SEGA[seg * 96 + sc_c] = A; SEGH[seg * 96 + sc_c] = H; }
        __syncthreads();
        if (tid < 384) { float Hin = 0.f, Ain = 1.f;
            for (int s2 = 0; s2 < seg; ++s2) { Hin = SEGA[s2 * 96 + sc_c] * Hin + SEGH[s2 * 96 + sc_c]; Ain *= SEGA[s2 * 96 + sc_c]; }
            unsigned* dst = HA + (rowbase + 32 * seg) * 768 + 96 * jb + sc_c;
#pragma unroll
            for (int t = 0; t < 32; ++t) { const float Hf = bv[t] + av[t] * Hin, Af = av[t] * Ain; dst[(size_t)t * 768] = cvtpk(Hf, Af);
                if (t == 31 && seg == 3) { HEND[(size_t)(b * 64 + n) * 768 + 96 * jb + sc_c] = Hf; AEND[(size_t)(b * 64 + n) * 768 + 96 * jb + sc_c] = Af; } } }
        __syncthreads();
    }
#undef LRU_LOAD
}

#define XB_TMO      128
#define XB_XCNT(j)  (256  + 64 * (j))
#define XB_XSUB(j)  (1280 + 64 * (j))
#define XB_XGEN(j)  (2304 + 64 * (j))
#define XB_TOP      3328
#define XB_TOPGEN   3392
#define XCD_BAR_WORDS 3456
#define XB_SPIN_CAP (1u << 18)

__device__ __forceinline__ unsigned xb_ld(unsigned* p)              { return __hip_atomic_load(p, __ATOMIC_RELAXED, __HIP_MEMORY_SCOPE_AGENT); }
__device__ __forceinline__ unsigned xb_add(unsigned* p, unsigned v) { return __hip_atomic_fetch_add(p, v, __ATOMIC_RELAXED, __HIP_MEMORY_SCOPE_AGENT); }
__device__ __forceinline__ unsigned xb_xcc_id() { return (unsigned)__builtin_amdgcn_s_getreg((3 << 11) | 20) & 0xFu; }
#define XB_SPIN(cond, bar) do { unsigned _sp = 0; while (cond) { __builtin_amdgcn_s_sleep(1); \
    if ((++_sp & 255u) == 0u) { if (xb_ld(&(bar)[XB_TMO])) break; if (_sp > XB_SPIN_CAP) { atomicAdd(&(bar)[XB_TMO], 1u); break; } } } } while (0)

struct XcdBarrier {
    unsigned* bar; unsigned x;
    volatile LAS unsigned* st;
};

__device__ __forceinline__ XcdBarrier xcd_barrier_post(unsigned* bar, volatile LAS unsigned* st) {
    XcdBarrier b; b.bar = bar; b.x = xb_xcc_id(); b.st = st;
    if (threadIdx.x == 0) (void)xb_add(&bar[XB_XCNT(b.x)], 1u);
    return b;
}
__device__ __forceinline__ void xcd_barrier_complete(unsigned* bar, unsigned x, unsigned& nloc, unsigned& nx) {
    const unsigned G = gridDim.x * gridDim.y * gridDim.z;
    unsigned sum, cnt, mine, sp = 0u;
    for (;;) {
        sum = 0u; cnt = 0u; mine = 0u;
#pragma unroll
        for (unsigned j = 0; j < 16; ++j) { const unsigned c = xb_ld(&bar[XB_XCNT(j)]); sum += c; cnt += (c > 0u) ? 1u : 0u; mine = (j == x) ? c : mine; }
        if (sum == G) break;
        __builtin_amdgcn_s_sleep(1);
        if ((++sp & 255u) == 0u) { if (xb_ld(&bar[XB_TMO])) break; if (sp > XB_SPIN_CAP) { atomicAdd(&bar[XB_TMO], 1u); break; } }
    }
    nloc = mine > 0u ? mine : 1u; nx = cnt > 0u ? cnt : 1u;
}

__device__ __forceinline__ void xcd_barrier(const XcdBarrier& b) {
    asm volatile("s_waitcnt vmcnt(0)" ::: "memory");
    __syncthreads();
    if (threadIdx.x == 0) {
        unsigned* bar = b.bar;
        __builtin_amdgcn_s_waitcnt(0);
        unsigned nloc = b.st[0], nx = b.st[1];
        if (nloc == 0u) { xcd_barrier_complete(bar, b.x, nloc, nx); b.st[0] = nloc; b.st[1] = nx; }
        const unsigned old = xb_add(&bar[XB_XSUB(b.x)], 1u);
        const unsigned gen = old / nloc;
        if (old + 1u == (gen + 1u) * nloc) {
            __builtin_amdgcn_fence(__ATOMIC_RELEASE, "agent");
            asm volatile("s_waitcnt vmcnt(0)" ::: "memory");
            const unsigned og = xb_add(&bar[XB_TOP], 1u);
            const unsigned tg = og / nx;
            if (og + 1u == (tg + 1u) * nx) xb_add(&bar[XB_TOPGEN], 1u);
            else XB_SPIN(xb_ld(&bar[XB_TOPGEN]) == tg, bar);
            __builtin_amdgcn_fence(__ATOMIC_ACQUIRE, "agent");
            xb_add(&bar[XB_XGEN(b.x)], 1u);
            asm volatile("s_waitcnt vmcnt(0)" ::: "memory");
        } else {
            XB_SPIN(xb_ld(&bar[XB_XGEN(b.x)]) == gen, bar);
            __builtin_amdgcn_fence(__ATOMIC_ACQUIRE, "agent");
            asm volatile("s_waitcnt vmcnt(0)" ::: "memory");
        }
    }
    __syncthreads();
}

#ifndef REP_P0
#define REP_P0 1
#endif
#ifndef REP_G1
#define REP_G1 1
#endif
#ifndef REP_AT
#define REP_AT 1
#endif
#ifndef REP_RK
#define REP_RK 1
#endif
#ifndef REP_LR
#define REP_LR 1
#endif
#ifndef REP_SC
#define REP_SC 1
#endif
#ifndef REP_RO
#define REP_RO 1
#endif
#ifndef REP_G2
#define REP_G2 1
#endif
#ifndef REP_FN
#define REP_FN 1
#endif
__global__ void __launch_bounds__(512) mega_fwd(Params p) {
    extern __shared__ __attribute__((aligned(16))) unsigned char lds_raw[];
    LAS unsigned char* L = (LAS unsigned char*)lds_raw;
    cg::grid_group grid = cg::this_grid();
    unsigned char* ws = p.ws;
    const int G = gridDim.x, bid = blockIdx.x, NGW = G * 8, NT = G * 512;
#define TIDS int tid = threadIdx.x; asm volatile("" : "+v"(tid)); const int lane = tid & 63, wave = tid >> 6, gw = bid * 8 + wave, gt = bid * 512 + tid; (void)lane; (void)gw; (void)gt;
    bf16_t* XB = (bf16_t*)(ws + WS_XB); bf16_t* MIXED = (bf16_t*)p.out;     bf16_t* PROJ = (bf16_t*)(ws + WS_PROJ); bf16_t* Y = (bf16_t*)(ws + WS_Y);
    float* KV = (float*)(ws + WS_KV); bf16_t* SP = (bf16_t*)(ws + WS_SP); unsigned* HA = (unsigned*)(ws + WS_HL);
    float* HEND = (float*)(ws + WS_HEND); float* AEND = (float*)(ws + WS_AEND); float* CARRY = (float*)(ws + WS_CARRY);
    float* RSTD = (float*)(ws + WS_RSTD); const bf16_t* LW = (const bf16_t*)(ws + WS_LRUW);
    const int lo = p.ph_lo, hi = p.ph_hi;
    volatile LAS unsigned* bst = (volatile LAS unsigned*)(L + LDS_BARST);
    if (threadIdx.x < 8) bst[threadIdx.x] = 0u;
    __syncthreads();
    XcdBarrier xbar; xbar.bar = (unsigned*)(ws + WS_BAR); xbar.x = 0; xbar.st = bst;
    if (hi - lo > 1) xbar = xcd_barrier_post((unsigned*)(ws + WS_BAR), bst);
    unsigned* cen = (unsigned*)(ws + WS_BAR) + 3584;
    if (threadIdx.x == 0 && hi - lo > 1) { const unsigned xcc = xb_xcc_id(); bst[2] = xcc; bst[3] = xb_add(&cen[xcc], 1u); }
#define IN(k) (lo <= (k) && (k) < hi)
#define SEAM(k) do { if (IN(k) && IN((k) + 1)) { if (p.ph_hi > 1000) grid.sync(); else xcd_barrier(xbar); } } while (0)
    if (IN(0)) { for (int rep_ = 0; rep_ < REP_P0; ++rep_) phase0(p, L); }
    SEAM(0);
    int vid = bid;
    if (hi - lo > 1) {
        if (threadIdx.x == 0) { bool ok = (G % 8) == 0; for (int j = 0; j < 16; ++j) { const unsigned cj = xb_ld(&cen[j]); ok = ok && (cj == (j < 8 ? (unsigned)(G / 8) : 0u)); }
            bst[4] = ok ? (bst[2] + 8u * bst[3]) : (unsigned)bid; }
        __syncthreads();
        vid = (int)bst[4];
    }
    vid = __builtin_amdgcn_readfirstlane(vid);
#pragma unroll 1
    for (int layer = 0; layer < 2; ++layer) {
        const int kb_ = 1 + 6 * layer;
        float* SSQ = (float*)(ws + WS_SSQ) + layer * M;
        if (IN(kb_ + 0)) for (int rep_ = 0; rep_ < REP_G1; ++rep_) {
            pg8::Gemm g{XB, (const bf16_t*)(ws + WS_WIN) + (size_t)layer * DIN * 2048, M, DIN, 2048}; pg8::StaticOrder S; S.init(M, DIN, G, vid);
            pg8::EpiProj E{PROJ, RSTD, (const float*)(ws + WS_COSR), (const float*)(ws + WS_SINR), (const float*)(ws + WS_COSD), (const float*)(ws + WS_SIND)};
            pg8::gemm_phase<pg8::EpiProj, pg8::StaticOrder, true, true>(L, g, S, E);
        }
        SEAM(kb_ + 0);
        if (IN(kb_ + 1)) {
            float d1 = 0.f, d2 = 0.f;
            for (int i = 0; i < 64; ++i) { d1 += p.lq1[layer * 64 + i] * p.lk1[layer * 64 + i]; d2 += p.lq2[layer * 64 + i] * p.lk2[layer * 64 + i]; }
            const float lam_init = 0.8f - 0.6f * expf(-0.3f * (float)layer);
            const float lam = expf(d1) - expf(d2) + lam_init;
            for (int rep_ = 0; rep_ < REP_AT; ++rep_) for (int pi = vid; pi < 256; pi += G) { const int bh = pi & 7, pp = pi >> 3;
                attn_item(L, PROJ, MIXED, p.subln_g + layer * 128, bh >> 2, bh & 3, 63 - pp, lam, 1.f - lam_init);
                attn_item(L, PROJ, MIXED, p.subln_g + layer * 128, bh >> 2, bh & 3, pp, lam, 1.f - lam_init); }
            ret_kv_phase(L, PROJ, KV, bid, G);
            for (int rep_ = 0; rep_ < REP_LR; ++rep_) lru_phase(L, p, layer, PROJ, LW, (const float*)(ws + WS_C8), HA, HEND, AEND, bid, G);
        }
        SEAM(kb_ + 1);
        if (IN(kb_ + 2)) for (int rep_ = 0; rep_ < REP_SC; ++rep_) {
            TIDS
            typedef float f32x2 __attribute__((ext_vector_type(2)));
            for (int idx = gt; idx < 12 * 8192; idx += NT) { const int bh = idx >> 13, ed = (idx & 8191) * 2; const float cd = fexp2(128.f * ret_log2g(bh % 6));
                const float* src = KV + (size_t)bh * 64 * 16384 + ed; bf16_t* dst = SP + (size_t)bh * 64 * 16384 + ed; float st0 = 0.f, st1 = 0.f;
                for (int n0 = 0; n0 < 64; n0 += 8) { f32x2 v[8];
#pragma unroll
                    for (int i = 0; i < 8; ++i) v[i] = __builtin_nontemporal_load((const f32x2*)(src + (size_t)(n0 + i) * 16384));
#pragma unroll
                    for (int i = 0; i < 8; ++i) { *(unsigned*)(dst + (size_t)(n0 + i) * 16384) = cvtpk(st0, st1); st0 = st0 * cd + v[i][0]; st1 = st1 * cd + v[i][1]; } } }
            for (int idx = gt; idx < 2 * 768; idx += NT) { const int b = idx / 768, c = idx - b * 768; float H = 0.f;
                for (int n0 = 0; n0 < 64; n0 += 8) { float a[8], hh[8];
#pragma unroll
                    for (int i = 0; i < 8; ++i) { a[i] = AEND[(size_t)(b * 64 + n0 + i) * 768 + c]; hh[i] = HEND[(size_t)(b * 64 + n0 + i) * 768 + c]; }
#pragma unroll
                    for (int i = 0; i < 8; ++i) { CARRY[(size_t)(b * 64 + n0 + i) * 768 + c] = H; H = a[i] * H + hh[i]; } } }
        }
        SEAM(kb_ + 2);
        if (IN(kb_ + 3)) for (int rep_ = 0; rep_ < REP_RO; ++rep_) {
            TIDS
            ret_out_phase(L, PROJ, SP, MIXED, bid, G);
            for (int idx = gt; idx < M * 96; idx += NT) { const int m = idx / 96, c = (idx - m * 96) * 8; const int bn = m >> 7;
                const u32x4 h0 = __builtin_nontemporal_load((const u32x4*)(HA + (size_t)m * 768 + c)), h1 = __builtin_nontemporal_load((const u32x4*)(HA + (size_t)m * 768 + c + 4)), lg = __builtin_nontemporal_load((const u32x4*)(PROJ + (size_t)m * DIN + C_LG + c));
                const f32x4 c0 = *(const f32x4*)(CARRY + (size_t)bn * 768 + c), c1 = *(const f32x4*)(CARRY + (size_t)bn * 768 + c + 4);
                u32x4 w;
                w.x = cvtpk((bflo(h0.x) + bfhi(h0.x) * c0[0]) * silu(bflo(lg.x)), (bflo(h0.y) + bfhi(h0.y) * c0[1]) * silu(bfhi(lg.x)));
                w.y = cvtpk((bflo(h0.z) + bfhi(h0.z) * c0[2]) * silu(bflo(lg.y)), (bflo(h0.w) + bfhi(h0.w) * c0[3]) * silu(bfhi(lg.y)));
                w.z = cvtpk((bflo(h1.x) + bfhi(h1.x) * c1[0]) * silu(bflo(lg.z)), (bflo(h1.y) + bfhi(h1.y) * c1[1]) * silu(bfhi(lg.z)));
                w.w = cvtpk((bflo(h1.z) + bfhi(h1.z) * c1[2]) * silu(bflo(lg.w)), (bflo(h1.w) + bfhi(h1.w) * c1[3]) * silu(bfhi(lg.w)));
                *(u32x4*)(MIXED + (size_t)m * 2048 + 1280 + c) = w; }
        }
        SEAM(kb_ + 3);
        if (IN(kb_ + 4)) for (int rep_ = 0; rep_ < REP_G2; ++rep_) {
            pg8::Gemm g{MIXED, (const bf16_t*)(ws + WS_WOUT) + (size_t)layer * 2048 * 2048, M, 2048, 2048}; pg8::StaticOrder S; S.init(M, 2048, G, vid);
            pg8::EpiY E{Y, rep_ == 0 ? SSQ : (float*)(ws + WS_KV)};
            pg8::gemm_phase<pg8::EpiY, pg8::StaticOrder, true, true>(L, g, S, E);
        }
        SEAM(kb_ + 4);
        if (IN(kb_ + 5)) for (int rep_ = 0; rep_ < REP_FN; ++rep_) {
            TIDS
            const float* pg = p.post_g + layer * 2048;
            for (int m = gw; m < M; m += NGW) {
                const float rs = 1.f / sqrtf(SSQ[m] * (1.f / 2048.f) + EPS); float s = 0.f; f32x4 xn[8];
#pragma unroll
                for (int j = 0; j < 4; ++j) { const int col = j * 512 + lane * 8; const u32x4 yw = __builtin_nontemporal_load((const u32x4*)(Y + (size_t)m * 2048 + col));
                    f32x4 x0, x1;
                    if (layer == 0) { x0 = __builtin_nontemporal_load((const f32x4*)(p.x + (size_t)m * 2048 + col)); x1 = __builtin_nontemporal_load((const f32x4*)(p.x + (size_t)m * 2048 + col + 4)); }
                    else { const u32x4 xw = __builtin_nontemporal_load((const u32x4*)(XB + (size_t)m * 2048 + col)); x0 = (f32x4){bflo(xw.x), bfhi(xw.x), bflo(xw.y), bfhi(xw.y)}; x1 = (f32x4){bflo(xw.z), bfhi(xw.z), bflo(xw.w), bfhi(xw.w)}; }
                    const f32x4 g0 = *(const f32x4*)(pg + col), g1 = *(const f32x4*)(pg + col + 4);
                    f32x4 a, bq; a[0] = x0[0] + bflo(yw.x) * rs * g0[0]; a[1] = x0[1] + bfhi(yw.x) * rs * g0[1]; a[2] = x0[2] + bflo(yw.y) * rs * g0[2]; a[3] = x0[3] + bfhi(yw.y) * rs * g0[3];
                    bq[0] = x1[0] + bflo(yw.z) * rs * g1[0]; bq[1] = x1[1] + bfhi(yw.z) * rs * g1[1]; bq[2] = x1[2] + bflo(yw.w) * rs * g1[2]; bq[3] = x1[3] + bfhi(yw.w) * rs * g1[3];
                    xn[2 * j] = a; xn[2 * j + 1] = bq; s += (a[0] * a[0] + a[1] * a[1]) + (a[2] * a[2] + a[3] * a[3]) + (bq[0] * bq[0] + bq[1] * bq[1]) + (bq[2] * bq[2] + bq[3] * bq[3]);
                    if (layer != 0) { __builtin_nontemporal_store(a, (f32x4*)(p.out + (size_t)m * 2048 + col)); __builtin_nontemporal_store(bq, (f32x4*)(p.out + (size_t)m * 2048 + col + 4)); } }
                if (layer == 0) { s = wave_sum(s); if (lane == 0) RSTD[m] = 1.f / sqrtf(s * (1.f / 2048.f) + EPS);
#pragma unroll
                    for (int j = 0; j < 4; ++j) { const f32x4 a = xn[2 * j], bq = xn[2 * j + 1]; u32x4 w; w.x = cvtpk(a[0], a[1]); w.y = cvtpk(a[2], a[3]); w.z = cvtpk(bq[0], bq[1]); w.w = cvtpk(bq[2], bq[3]);
                        *(u32x4*)(XB + (size_t)m * 2048 + j * 512 + lane * 8) = w; } }
            }
        }
        SEAM(kb_ + 5);
    }
#undef IN
#undef SEAM
}

#ifndef MK_MULTI
#define MK_MULTI 0
#endif
constexpr int N_PHASES = 13;
extern "C" void kernel_launch(void* const* d_in, const int* in_sizes, int n_in, void* d_out, int out_size, void* d_ws, size_t ws_size, hipStream_t stream) {
    static int grid = 0;
    if (grid == 0) {
        if (n_in != 18 || ws_size < WS_END) { fprintf(stderr, "kernel_launch: unexpected inputs (n_in %d, ws %zu)\n", n_in, ws_size); grid = -1; return; }
        int dev = 0, cus = 0, per_cu = 0;
        hipGetDevice(&dev); hipDeviceGetAttribute(&cus, hipDeviceAttributeMultiprocessorCount, dev);
        hipFuncSetAttribute((const void*)mega_fwd, hipFuncAttributeMaxDynamicSharedMemorySize, LDS_BYTES);
        if (hipOccupancyMaxActiveBlocksPerMultiprocessor(&per_cu, (const void*)mega_fwd, 512, LDS_BYTES) != hipSuccess || per_cu < 1) per_cu = 1;
        (void)hipGetLastError();
        grid = cus * per_cu;
    }
    if (grid < 0) return;
    Params p{};
    p.x = (const float*)d_in[0]; p.pos = (const int*)d_in[1]; p.pre_g = (const float*)d_in[2]; p.w_in = (const float*)d_in[3];
    p.lq1 = (const float*)d_in[4]; p.lk1 = (const float*)d_in[5]; p.lq2 = (const float*)d_in[6]; p.lk2 = (const float*)d_in[7];
    p.subln_g = (const float*)d_in[8]; p.conv_w = (const float*)d_in[9]; p.conv_b = (const float*)d_in[10]; p.wa = (const float*)d_in[11]; p.ba = (const float*)d_in[12];
    p.wx = (const float*)d_in[13]; p.bx = (const float*)d_in[14]; p.lru_lam = (const float*)d_in[15]; p.w_out = (const float*)d_in[16]; p.post_g = (const float*)d_in[17];
    p.out = (float*)d_out; p.ws = (unsigned char*)d_ws;
#if MK_MULTI
    for (int ph = 0; ph < N_PHASES; ++ph) { p.ph_lo = ph; p.ph_hi = ph + 1; hipLaunchKernelGGL(mega_fwd, dim3(grid), dim3(512), LDS_BYTES, stream, p); }
#else
    p.ph_lo = 0; p.ph_hi = N_PHASES;
    if (hipMemsetAsync((char*)d_ws + WS_BAR, 0, WS_BAR_BYTES, stream) != hipSuccess) { fprintf(stderr, "kernel_launch: memset of barrier words failed\n"); return; }
    void* args[] = {&p};
    hipError_t e = hipLaunchCooperativeKernel((const void*)mega_fwd, dim3(grid), dim3(512), args, LDS_BYTES, stream);
    if (e != hipSuccess) fprintf(stderr, "cooperative launch failed: %s (grid %d)\n", hipGetErrorString(e), grid);
#endif
}
```

```cpp
#include <hip/hip_runtime.h>
#include <hip/hip_cooperative_groups.h>
#include <cstdio>
#include <cstdint>
namespace cg = cooperative_groups;
namespace pg8 {
#define PG8_LAS __attribute__((address_space(3)))
typedef unsigned short bf16_t;
typedef short bf16x8 __attribute__((ext_vector_type(8)));
typedef float f32x4 __attribute__((ext_vector_type(4)));
typedef unsigned u32x4 __attribute__((ext_vector_type(4)));
constexpr int BM = 256, BK = 64, HALF = 128, HTB = HALF * BK * 2  , STAGE_BYTES = 8 * HTB, NXCD = 8, WGM = 4;

__host__ __device__ __forceinline__ int lds_byte(int r, int c) { const int st = (r >> 4) * 2 + (c >> 5), rr = r & 15, cc = c & 31, ob = rr * 64 + cc * 2; return st * 1024 + (ob ^ (((ob >> 9) & 1) << 5)); }
__host__ __device__ __forceinline__ void stage_rc(int b, int& R, int& C) { const int st = b / 1024, sb = b % 1024, swz = sb ^ (((sb >> 9) & 1) << 5); R = (st >> 1) * 16 + swz / 64; C = (st & 1) * 32 + (swz % 64) / 2; }
__host__ __device__ __forceinline__ int perm32(int rho) { const int n = rho >> 4, i = rho & 15; return 8 * (i >> 2) + 4 * n + (i & 3); }

struct Unit { int pm, pn; };
struct Gemm { const bf16_t* A; const bf16_t* Bt; int M, N, K; };

struct StaticOrder {
    int nM, nN, nwg, G, c;
    __host__ __device__ void init(int M, int N, int G_, int c_) { nM = M / BM; nN = N / BM; nwg = nM * nN; G = G_; c = c_; }
    __host__ __device__ bool next(int i, Unit& u) const {
        const long L = (long)i * G + c; if (L >= nwg) return false;
        int wgid = (int)L; { const int q = nwg / NXCD, r = nwg % NXCD, xcd = wgid % NXCD, off = wgid / NXCD; wgid = (xcd < r ? xcd * (q + 1) : r * (q + 1) + (xcd - r) * q) + off; }
        const int nig = WGM * nN, gid = wgid / nig, fm = gid * WGM, gsz = (nM - fm) < WGM ? (nM - fm) : WGM;
        u.pm = fm + ((wgid % nig) % gsz); u.pn = (wgid % nig) / gsz; return true;
    }
    __device__ __forceinline__ void a_ready(const Unit&) const {}
    __device__ __forceinline__ void done(const Unit&) const {}
};
__device__ __forceinline__ unsigned cvt_pk_bf16(float lo, float hi) { unsigned r; asm volatile("v_cvt_pk_bf16_f32 %0, %1, %2" : "=v"(r) : "v"(lo), "v"(hi)); return r; }
typedef float f32x2 __attribute__((ext_vector_type(2)));
typedef unsigned u32x4 __attribute__((ext_vector_type(4)));
struct EpiProj {
    static constexpr bool PERM = true, AFTER_DRAIN = false;
    bf16_t* O; const float* rstd; const float* cosR; const float* sinR; const float* cosD; const float* sinD;
    __device__ __forceinline__ void operator()(const f32x4 (&acc)[2][2][4][2], const Unit& u, int wr, int wc, int fr, int fq) const {
        const int row0 = u.pm * BM + wr * 64 + fr; const int colt = u.pn * BM;
        int mode = 0; float sc = 1.f;
        if (colt < 768) { mode = 1; } else if (colt < 1536) { mode = 1; sc = 0.08838834764831845f; }
        else if (colt >= 3072 && colt < 3584) { mode = 2; sc = 0.125f * 1.4426950408889634f; } else if (colt >= 3584 && colt < 4096) { mode = 2; }
        const int colw = colt + wc * 32 + 8 * fq;
#pragma unroll
        for (int ai = 0; ai < 2; ++ai)
#pragma unroll
            for (int m = 0; m < 4; ++m) { const int row = row0 + ai * HALF + m * 16; const float rs = rstd[row] * sc;
#pragma unroll
                for (int bj = 0; bj < 2; ++bj) { const int col0 = colw + bj * HALF; f32x4 v0 = acc[ai][bj][m][0] * rs, v1 = acc[ai][bj][m][1] * rs;
                    if (mode != 0) {
                        f32x4 cs, sn;
                        if (mode == 1) { const int i0 = (col0 & 127) >> 1; cs = *(const f32x4*)(cosR + (size_t)row * 64 + i0); sn = *(const f32x4*)(sinR + (size_t)row * 64 + i0); }
                        else { const int i0 = (col0 & 63) >> 1; cs = *(const f32x4*)(cosD + (size_t)row * 32 + i0); sn = *(const f32x4*)(sinD + (size_t)row * 32 + i0); }
                        f32x4 w0, w1;
                        w0[0] = v0[0] * cs[0] - v0[1] * sn[0]; w0[1] = v0[1] * cs[0] + v0[0] * sn[0];
                        w0[2] = v0[2] * cs[1] - v0[3] * sn[1]; w0[3] = v0[3] * cs[1] + v0[2] * sn[1];
                        w1[0] = v1[0] * cs[2] - v1[1] * sn[2]; w1[1] = v1[1] * cs[2] + v1[0] * sn[2];
                        w1[2] = v1[2] * cs[3] - v1[3] * sn[3]; w1[3] = v1[3] * cs[3] + v1[2] * sn[3];
                        v0 = w0; v1 = w1;
                    }
                    u32x4 w; w.x = cvt_pk_bf16(v0[0], v0[1]); w.y = cvt_pk_bf16(v0[2], v0[3]); w.z = cvt_pk_bf16(v1[0], v1[1]); w.w = cvt_pk_bf16(v1[2], v1[3]);
                    *(u32x4*)(O + (size_t)row * 6656 + col0) = w; } }
    }
};
struct EpiY {
    static constexpr bool PERM = true, AFTER_DRAIN = false;
    bf16_t* Y; float* ssq;
    __device__ __forceinline__ void operator()(const f32x4 (&acc)[2][2][4][2], const Unit& u, int wr, int wc, int fr, int fq) const {
        const int row0 = u.pm * BM + wr * 64 + fr; const int colw = u.pn * BM + wc * 32 + 8 * fq;
#pragma unroll
        for (int ai = 0; ai < 2; ++ai)
#pragma unroll
            for (int m = 0; m < 4; ++m) { const int row = row0 + ai * HALF + m * 16; float s = 0.f;
#pragma unroll
                for (int bj = 0; bj < 2; ++bj) { const f32x4 v0 = acc[ai][bj][m][0], v1 = acc[ai][bj][m][1];
                    s += (v0[0] * v0[0] + v0[1] * v0[1]) + (v0[2] * v0[2] + v0[3] * v0[3]) + (v1[0] * v1[0] + v1[1] * v1[1]) + (v1[2] * v1[2] + v1[3] * v1[3]);
                    u32x4 w; w.x = cvt_pk_bf16(v0[0], v0[1]); w.y = cvt_pk_bf16(v0[2], v0[3]); w.z = cvt_pk_bf16(v1[0], v1[1]); w.w = cvt_pk_bf16(v1[2], v1[3]);
                    *(u32x4*)(Y + (size_t)row * 2048 + colw + bj * HALF) = w; }
                s += __shfl_xor(s, 16); s += __shfl_xor(s, 32);
                if (fq == 0) unsafeAtomicAdd(ssq + row, s); }
    }
};
template <class Epi, class Sched, bool ALIGN_EPI = false, bool SP2 = false>
__device__ __forceinline__ void gemm_phase(PG8_LAS unsigned char* lds, const Gemm g, const Sched& S, const Epi& E) {
    int tid = threadIdx.x; asm volatile("" : "+v"(tid)); const int wid = __builtin_amdgcn_readfirstlane(tid >> 6), lane = tid & 63, wr = wid >> 2, wc = wid & 3, fr = lane & 15, fq = lane >> 4;
    const int K = g.K, nt = K / BK;
    unsigned voffA[2], voffB[2];
#pragma unroll
    for (int i = 0; i < 2; ++i) { int R, C; stage_rc(tid * 16 + i * 8192, R, C); const int Rb = Epi::PERM ? ((R & ~31) + perm32(R & 31)) : R;
        voffA[i] = (unsigned)(R * K + C) * 2u; voffB[i] = (unsigned)(Rb * K + C) * 2u; }
    const size_t kstep = (size_t)(BK * 2);
    const size_t hstep = (size_t)HALF * K * 2;
    const size_t tstep = 2 * hstep;
    const unsigned ldsw = (unsigned)wid * 1024u;
    const int aoff = lds_byte(wr * 64 + fr, fq * 8), boff = lds_byte(wc * 32 + fr, fq * 8);
#define PG8_SA(b, h) (((b) * 2 + (h)) * HTB)
#define PG8_SB(b, h) ((4 + (b) * 2 + (h)) * HTB)
#define PG8_STAGE(bufoff, gbase, voff) do { _Pragma("unroll") for (int _i = 0; _i < 2; ++_i) \
        __builtin_amdgcn_global_load_lds((const unsigned*)((const char*)(gbase) + (voff)[_i]), (PG8_LAS unsigned*)(lds + (bufoff) + ldsw + _i * 8192), 16, 0, 0); } while (0)
#define PG8_LDA(dst, b, h) do { _Pragma("unroll") for (int m = 0; m < 4; ++m) _Pragma("unroll") for (int k = 0; k < 2; ++k) dst[m][k] = *(const PG8_LAS bf16x8*)(lds + PG8_SA(b, h) + aoff + m * 2048 + k * 1024); } while (0)
#define PG8_LDB(dst, b, h) do { _Pragma("unroll") for (int n = 0; n < 2; ++n) _Pragma("unroll") for (int k = 0; k < 2; ++k) dst[n][k] = *(const PG8_LAS bf16x8*)(lds + PG8_SB(b, h) + boff + n * 2048 + k * 1024); } while (0)
#define PG8_MMA(ai, bj, At, Bt) do { __builtin_amdgcn_s_setprio(1); _Pragma("unroll") for (int m = 0; m < 4; ++m) _Pragma("unroll") for (int n = 0; n < 2; ++n) _Pragma("unroll") for (int k = 0; k < 2; ++k) \
        acc[ai][bj][m][n] = __builtin_amdgcn_mfma_f32_16x16x32_bf16(Bt[n][k], At[m][k], acc[ai][bj][m][n], 0, 0, 0); __builtin_amdgcn_s_setprio(0); } while (0)
#define PG8_WAIT_V(n) asm volatile("s_waitcnt vmcnt(" #n ")" ::: "memory")
#define PG8_WAIT_L(n) asm volatile("s_waitcnt lgkmcnt(" #n ")" ::: "memory")
#define PG8_BAR __builtin_amdgcn_s_barrier()
#define PG8_SCHED __builtin_amdgcn_sched_barrier(0)
    Unit cur, nxt; int ui = 0;
    if (!S.next(0, cur)) return;
    f32x4 acc[2][2][4][2];
#pragma unroll
    for (int a = 0; a < 2; ++a)
#pragma unroll
        for (int b = 0; b < 2; ++b)
#pragma unroll
            for (int m = 0; m < 4; ++m)
#pragma unroll
                for (int n = 0; n < 2; ++n) acc[a][b][m][n] = (f32x4){0.f, 0.f, 0.f, 0.f};
    bf16x8 At[4][2], B0[2][2], B1[2][2];
    const char* cA = (const char*)g.A + (size_t)cur.pm * tstep; const char* cB = (const char*)g.Bt + (size_t)cur.pn * tstep;
    S.a_ready(cur);
    if constexpr (SP2) {
        PG8_STAGE(PG8_SB(0, 0), cB, voffB); PG8_STAGE(PG8_SB(0, 1), cB + hstep, voffB); PG8_STAGE(PG8_SA(0, 0), cA, voffA); PG8_STAGE(PG8_SA(0, 1), cA + hstep, voffA);
        if (wr == 1) PG8_BAR;
        PG8_WAIT_V(2); PG8_BAR;
        PG8_STAGE(PG8_SB(1, 0), cB + kstep, voffB); PG8_STAGE(PG8_SA(1, 0), cA + kstep, voffA); PG8_STAGE(PG8_SB(1, 1), cB + hstep + kstep, voffB);
        PG8_WAIT_V(6); PG8_BAR;
    } else {
        PG8_STAGE(PG8_SB(0, 0), cB, voffB); PG8_STAGE(PG8_SA(0, 0), cA, voffA); PG8_STAGE(PG8_SB(0, 1), cB + hstep, voffB); PG8_STAGE(PG8_SA(0, 1), cA + hstep, voffA);
        if (wr == 1) PG8_BAR;
        PG8_WAIT_V(4); PG8_BAR;
        PG8_STAGE(PG8_SB(1, 0), cB + kstep, voffB); PG8_STAGE(PG8_SA(1, 0), cA + kstep, voffA); PG8_STAGE(PG8_SB(1, 1), cB + hstep + kstep, voffB);
        PG8_WAIT_V(6); PG8_BAR;
    }
    for (;;) {
        const bool has_next = S.next(ui + 1, nxt);
        const char* nA = has_next ? (const char*)g.A + (size_t)nxt.pm * tstep : cA; const char* nB = has_next ? (const char*)g.Bt + (size_t)nxt.pn * tstep : cB;
        for (int t = 0; t < nt; t += 2) {
            const bool last = (t == nt - 2);
            const char* a1 = cA + (size_t)(t + 1) * kstep;
            const char* a2 = last ? nA : cA + (size_t)(t + 2) * kstep; const char* b2 = last ? nB : cB + (size_t)(t + 2) * kstep;
            const char* a3 = a2 + kstep; const char* b3 = b2 + kstep;
            if (last && has_next) S.a_ready(nxt);
            if constexpr (SP2) {
            PG8_LDB(B0, 0, 0); PG8_LDB(B1, 0, 1); PG8_SCHED; PG8_LDA(At, 0, 0); PG8_STAGE(PG8_SA(1, 1), a1 + hstep, voffA);
            PG8_WAIT_V(8); PG8_WAIT_L(0); PG8_BAR; PG8_MMA(0, 0, At, B0); PG8_MMA(0, 1, At, B1); PG8_BAR; PG8_SCHED;
            PG8_LDA(At, 0, 1); PG8_STAGE(PG8_SB(0, 0), b2, voffB); PG8_STAGE(PG8_SB(0, 1), b2 + hstep, voffB); PG8_STAGE(PG8_SA(0, 0), a2, voffA);
            PG8_WAIT_V(8); PG8_WAIT_L(0); PG8_BAR; PG8_MMA(1, 0, At, B0); PG8_MMA(1, 1, At, B1); PG8_BAR; PG8_SCHED;
            PG8_LDB(B0, 1, 0); PG8_LDB(B1, 1, 1); PG8_SCHED; PG8_LDA(At, 1, 0); PG8_STAGE(PG8_SA(0, 1), a2 + hstep, voffA);
            PG8_WAIT_V(8); PG8_WAIT_L(0); PG8_BAR; PG8_MMA(0, 0, At, B0); PG8_MMA(0, 1, At, B1); PG8_BAR; PG8_SCHED;
            PG8_LDA(At, 1, 1); PG8_STAGE(PG8_SB(1, 0), b3, voffB); PG8_STAGE(PG8_SB(1, 1), b3 + hstep, voffB); PG8_STAGE(PG8_SA(1, 0), a3, voffA);
            PG8_WAIT_V(8); PG8_WAIT_L(0); PG8_BAR; PG8_MMA(1, 0, At, B0); PG8_MMA(1, 1, At, B1); PG8_BAR; PG8_SCHED;
            } else {
            PG8_LDB(B0, 0, 0); PG8_SCHED; PG8_LDA(At, 0, 0); PG8_STAGE(PG8_SA(1, 1), a1 + hstep, voffA);
            PG8_WAIT_L(8); PG8_BAR; PG8_WAIT_L(0); PG8_MMA(0, 0, At, B0); PG8_BAR; PG8_SCHED;
            PG8_LDB(B1, 0, 1); PG8_STAGE(PG8_SB(0, 0), b2, voffB);
            PG8_BAR; PG8_WAIT_L(0); PG8_MMA(0, 1, At, B1); PG8_BAR;
            PG8_LDA(At, 0, 1); PG8_STAGE(PG8_SA(0, 0), a2, voffA);
            PG8_BAR; PG8_WAIT_L(0); PG8_MMA(1, 0, At, B0); PG8_BAR; PG8_SCHED;
            PG8_STAGE(PG8_SB(0, 1), b2 + hstep, voffB);
            PG8_WAIT_V(6); PG8_BAR; PG8_MMA(1, 1, At, B1); PG8_BAR;
            PG8_LDB(B0, 1, 0); PG8_SCHED; PG8_LDA(At, 1, 0); PG8_STAGE(PG8_SA(0, 1), a2 + hstep, voffA);
            PG8_WAIT_L(8); PG8_BAR; PG8_WAIT_L(0); PG8_MMA(0, 0, At, B0); PG8_BAR; PG8_SCHED;
            PG8_LDB(B1, 1, 1); PG8_STAGE(PG8_SB(1, 0), b3, voffB);
            PG8_BAR; PG8_WAIT_L(0); PG8_MMA(0, 1, At, B1); PG8_BAR;
            PG8_LDA(At, 1, 1); PG8_STAGE(PG8_SA(1, 0), a3, voffA);
            PG8_BAR; PG8_WAIT_L(0); PG8_MMA(1, 0, At, B0); PG8_BAR; PG8_SCHED;
            PG8_STAGE(PG8_SB(1, 1), b3 + hstep, voffB);
            PG8_WAIT_V(6); PG8_BAR; PG8_MMA(1, 1, At, B1); PG8_BAR;
            }
        }
        if constexpr (ALIGN_EPI) { if (wr == 0) PG8_BAR; }
        if constexpr (!Epi::AFTER_DRAIN) { E(acc, cur, wr, wc, fr, fq); S.done(cur); }
        if (!has_next) break;
#pragma unroll
        for (int a = 0; a < 2; ++a)
#pragma unroll
            for (int b = 0; b < 2; ++b)
#pragma unroll
                for (int m = 0; m < 4; ++m)
#pragma unroll
                    for (int n = 0; n < 2; ++n) acc[a][b][m][n] = (f32x4){0.f, 0.f, 0.f, 0.f};
        cur = nxt; cA = nA; cB = nB; ++ui;
        if constexpr (ALIGN_EPI) { if (wr == 1) PG8_BAR; }
    }
    PG8_WAIT_V(0);
    if constexpr (!ALIGN_EPI) { if (wr == 0) PG8_BAR; }
    PG8_BAR;
    if constexpr (Epi::AFTER_DRAIN) { E.fused(acc, cur, wr, wc, fr, fq, lds, wid, lane); S.done(cur); }
#undef PG8_SA
#undef PG8_SB
#undef PG8_STAGE
#undef PG8_LDA
#undef PG8_LDB
#undef PG8_MMA
#undef PG8_WAIT_V
#undef PG8_WAIT_L
#undef PG8_BAR
#undef PG8_SCHED
}
}
#define LAS __attribute__((address_space(3)))
typedef unsigned short bf16_t;
typedef short bf16x8 __attribute__((ext_vector_type(8)));
typedef short s16x4 __attribute__((ext_vector_type(4)));
typedef float f32x4 __attribute__((ext_vector_type(4)));
typedef float f32x16 __attribute__((ext_vector_type(16)));
typedef unsigned u32x4 __attribute__((ext_vector_type(4)));
constexpr int BATCH = 2, SEQ = 8192, DM = 2048, M = BATCH * SEQ, DIN = 6656;
constexpr int C_RQ = 0, C_RK = 768, C_RV = 1536, C_RG = 2304, C_DQ = 3072, C_DK = 3584, C_DV = 4096, C_DG = 4608, C_LX = 5120, C_LG = 5888;
constexpr float EPS = 1e-6f;
constexpr size_t MiB = 1u << 20;
constexpr size_t WS_SSQ = 0, WS_RSTD = 128 * 1024, WS_BAR = 256 * 1024, WS_BAR_BYTES = 16384, WS_C8 = 320 * 1024;
constexpr size_t WS_COSR = 1 * MiB, WS_SINR = 5 * MiB, WS_COSD = 9 * MiB, WS_SIND = 11 * MiB, WS_LRUW = 13 * MiB;
constexpr size_t WS_HEND = 14 * MiB, WS_AEND = 14 * MiB + 512 * 1024, WS_CARRY = 15 * MiB;
constexpr size_t WS_WIN = 16 * MiB, WS_WOUT = 68 * MiB, WS_XB = 84 * MiB, WS_PROJ = 148 * MiB, WS_KV = 356 * MiB, WS_SP = 404 * MiB, WS_HL = 428 * MiB, WS_AC = 452 * MiB, WS_END = 476 * MiB;
constexpr size_t WS_MIXED = WS_XB, WS_Y = WS_PROJ;
constexpr int LDS_BYTES = 147456, LDS_BARST = 147200;

struct Params {
    const float* x; const int* pos; const float* pre_g; const float* w_in; const float* lq1; const float* lk1; const float* lq2; const float* lk2;
    const float* subln_g; const float* conv_w; const float* conv_b; const float* wa; const float* ba; const float* wx; const float* bx; const float* lru_lam;
    const float* w_out; const float* post_g; float* out; unsigned char* ws; int ph_lo, ph_hi;
};

#define MFMA32(a, b, c) __builtin_amdgcn_mfma_f32_32x32x16_bf16((a), (b), (c), 0, 0, 0)
__device__ __forceinline__ unsigned cvtpk(float lo, float hi) { return pg8::cvt_pk_bf16(lo, hi); }
__device__ __forceinline__ float bflo(unsigned w) { return __uint_as_float(w << 16); }
__device__ __forceinline__ float bfhi(unsigned w) { return __uint_as_float(w & 0xffff0000u); }
__device__ __forceinline__ int crow(int r, int hi) { return (r & 3) + 8 * (r >> 2) + 4 * hi; }
typedef short v4i16_t __attribute__((ext_vector_type(4)));
__device__ __forceinline__ s16x4 tr_read(const LAS unsigned char* p) { return __builtin_bit_cast(s16x4, __builtin_amdgcn_ds_read_tr16_b64_v4i16((LAS v4i16_t*)p)); }
__device__ __forceinline__ bf16x8 cat8(s16x4 lo, s16x4 hi) { return __builtin_shufflevector(lo, hi, 0, 1, 2, 3, 4, 5, 6, 7); }
__device__ __forceinline__ bf16x8 pack8(const f32x16& s, int b) { u32x4 w; w.x = cvtpk(s[b], s[b + 1]); w.y = cvtpk(s[b + 2], s[b + 3]); w.z = cvtpk(s[b + 4], s[b + 5]); w.w = cvtpk(s[b + 6], s[b + 7]); return __builtin_bit_cast(bf16x8, w); }
__device__ __forceinline__ float wave_sum(float v) {
#pragma unroll
    for (int o = 1; o < 64; o <<= 1) v += __shfl_xor(v, o);
    return v;
}
__device__ __forceinline__ float fexp2(float x) { return __builtin_amdgcn_exp2f(x); }
__device__ __forceinline__ float sigm(float x) { return 1.f / (1.f + __expf(-x)); }
__device__ __forceinline__ float silu(float x) { return x / (1.f + __expf(-x)); }
__device__ __forceinline__ float ret_log2g(int h) { return log2f(1.f - exp2f(-5.f - (float)h)); }

__device__ __forceinline__ int src_col_in(int n) {
    if (n < 1536) { const int cn = n & 127; return (n - cn) + (cn >> 1) + 64 * (cn & 1); }
    if (n >= 3072 && n < 4096) { const int cn = n & 63; return (n - cn) + (cn >> 1) + 32 * (cn & 1); }
    return n;
}
__device__ __forceinline__ void p0_transpose_item(const float* W, int K, int N, bf16_t* WT, const float* gk, bool perm, LAS float* scr, int item, int lane, bool late) {
    const int nblk = N / 32, kb = item / nblk, nb = item % nblk, k0 = 64 * kb, n0 = 32 * nb;
    const int krow = lane >> 3, part = lane & 7;
    int srcc = n0 + 4 * part, dst0 = 4 * part, dstep = 1;
    if (perm && (n0 < 1536 || (n0 >= 3072 && n0 < 4096))) {
        const int H = n0 < 1536 ? 128 : 64, cn0 = n0 & (H - 1), seg = part >> 2, j4 = part & 3;
        srcc = (n0 - cn0) + (cn0 >> 1) + 4 * j4 + seg * (H >> 1); dst0 = 8 * j4 + seg; dstep = 2;
    }
#pragma unroll
    for (int i = 0; i < 8; ++i) { const int kk = 8 * i + krow; f32x4 v = __builtin_nontemporal_load((const f32x4*)(W + (size_t)(k0 + kk) * N + srcc));     if (gk) v = v * gk[k0 + kk];
        LAS float* d = scr + kk * 33 + dst0; d[0] = v[0]; d[dstep] = v[1]; d[2 * dstep] = v[2]; d[3 * dstep] = v[3]; }
    asm volatile("s_waitcnt lgkmcnt(0)" ::: "memory");
    const int c = lane & 7;
#pragma unroll
    for (int j = 0; j < 4; ++j) { const int n = (lane >> 3) + 8 * j; const LAS float* s = scr + (8 * c) * 33 + n;
        u32x4 o; o.x = cvtpk(s[0 * 33], s[1 * 33]); o.y = cvtpk(s[2 * 33], s[3 * 33]); o.z = cvtpk(s[4 * 33], s[5 * 33]); o.w = cvtpk(s[6 * 33], s[7 * 33]);
        if (late) __builtin_nontemporal_store(o, (u32x4*)(WT + (size_t)(n0 + n) * K + k0 + 8 * c)); else *(u32x4*)(WT + (size_t)(n0 + n) * K + k0 + 8 * c) = o; }
    asm volatile("s_waitcnt lgkmcnt(0)" ::: "memory");
}
__device__ __forceinline__ void sincos_d(double a, float& s, float& c) {
    const double kq = rint(a * 0.63661977236758134308);
    double r = fma(-kq, 1.57079632679489655800e+00, a); r = fma(-kq, 6.12323399573676603587e-17, r);
    const int q = (int)((long long)kq & 3);
    const double r2 = r * r;
    const double sp = r * (1.0 + r2 * (-1.0 / 6.0 + r2 * (1.0 / 120.0 + r2 * (-1.0 / 5040.0 + r2 * (1.0 / 362880.0 + r2 * (-1.0 / 39916800.0 + r2 * (1.0 / 6227020800.0)))))));
    const double cp = 1.0 + r2 * (-0.5 + r2 * (1.0 / 24.0 + r2 * (-1.0 / 720.0 + r2 * (1.0 / 40320.0 + r2 * (-1.0 / 3628800.0 + r2 * (1.0 / 479001600.0))))));
    const double ss = (q & 1) ? cp : sp, cc = (q & 1) ? sp : cp;
    s = (float)((q & 2) ? -ss : ss); c = (float)(((q + 1) & 2) ? -cc : cc);
}
__device__ __forceinline__ void phase0(const Params& p, LAS unsigned char* L) {
    int tid = threadIdx.x; asm volatile("" : "+v"(tid)); const int lane = tid & 63, wave = tid >> 6;
    const int gw = blockIdx.x * 8 + wave, NGW = gridDim.x * 8, gt = blockIdx.x * 512 + tid, NT = gridDim.x * 512;
    unsigned char* ws = p.ws;
    LAS float* scr = (LAS float*)(L + wave * 16384);
    constexpr int I_IN = 32 * 208, I_OUT = 32 * 64, I_L = I_IN + I_OUT;
    for (int it = gw; it < 2 * I_L; it += NGW) {
        const int layer = it / I_L, r = it - layer * I_L;
        if (r < I_IN) p0_transpose_item(p.w_in + (size_t)layer * 2048 * DIN, 2048, DIN, (bf16_t*)(ws + WS_WIN) + (size_t)layer * DIN * 2048, p.pre_g + layer * 2048, true, scr, r, lane, layer != 0);
        else p0_transpose_item(p.w_out + (size_t)layer * 2048 * 2048, 2048, 2048, (bf16_t*)(ws + WS_WOUT) + (size_t)layer * 2048 * 2048, nullptr, false, scr, r - I_IN, lane, true);
    }
    float* rstd = (float*)(ws + WS_RSTD); bf16_t* XB = (bf16_t*)(ws + WS_XB);
    for (int m = gw; m < M; m += NGW) {
        const float* xr = p.x + (size_t)m * DM; f32x4 v[8]; float s = 0.f;
#pragma unroll
        for (int j = 0; j < 4; ++j) { v[2 * j] = __builtin_nontemporal_load((const f32x4*)(xr + j * 512 + lane * 8)); v[2 * j + 1] = __builtin_nontemporal_load((const f32x4*)(xr + j * 512 + lane * 8 + 4));
            const f32x4 a = v[2 * j], b = v[2 * j + 1]; s += (a[0] * a[0] + a[1] * a[1]) + (a[2] * a[2] + a[3] * a[3]) + (b[0] * b[0] + b[1] * b[1]) + (b[2] * b[2] + b[3] * b[3]); }
        s = wave_sum(s);
        if (lane == 0) rstd[m] = 1.f / sqrtf(s * (1.f / DM) + EPS);
#pragma unroll
        for (int j = 0; j < 4; ++j) { const f32x4 a = v[2 * j], b = v[2 * j + 1]; u32x4 w; w.x = cvtpk(a[0], a[1]); w.y = cvtpk(a[2], a[3]); w.z = cvtpk(b[0], b[1]); w.w = cvtpk(b[2], b[3]);
            *(u32x4*)(XB + (size_t)m * DM + j * 512 + lane * 8) = w; }
    }
    float* cosR = (float*)(ws + WS_COSR); float* sinR = (float*)(ws + WS_SINR); float* cosD = (float*)(ws + WS_COSD); float* sinD = (float*)(ws + WS_SIND);
    for (int e = gt; e < M * 96; e += NT) {
        const int m = e / 96, f = e - m * 96; const double pos = (double)p.pos[m];
        float s, c;
        if (f < 64) { const double inv = exp(-((double)f / 63.0) * 9.210340371976184); sincos_d(pos * inv, s, c); cosR[(size_t)m * 64 + f] = c; sinR[(size_t)m * 64 + f] = s; }
        else { const int i = f - 64; const double inv = exp(-((double)(2 * i) / 64.0) * 9.210340371976184); sincos_d(pos * inv, s, c); cosD[(size_t)m * 32 + i] = c; sinD[(size_t)m * 32 + i] = s; }
    }
    float* ssq = (float*)(ws + WS_SSQ);
    for (int e = gt; e < 2 * M; e += NT) ssq[e] = 0.f;
    float* C8 = (float*)(ws + WS_C8);
    for (int e = gt; e < 2 * 768; e += NT) C8[e] = -8.f * log1pf(expf(-p.lru_lam[e]));
    bf16_t* LW = (bf16_t*)(ws + WS_LRUW);
    for (int e = gt; e < 2 * 2 * 8 * 96 * 96; e += NT) {
        const int k = e % 96, j = (e / 96) % 96, n = (e / 9216) % 8, gate = (e / 73728) % 2, l = e / 147456;
        const float v = (gate ? p.wx : p.wa)[(size_t)((l * 8 + n) * 96 + k) * 96 + j];
        LW[e] = (bf16_t)(cvtpk(v, 0.f) & 0xffffu);
    }
}
constexpr int AT_KP = 272, AT_VP = 320, AT_KB = 64 * AT_KP, AT_VB = 64 * AT_VP, AT_KOFF = 0, AT_VOFF = 2 * AT_KB, AT_XOFF = 0, AT_EOFF = 65536, E_PITCH = 132;
__device__ __forceinline__ float max3f(float a, float b, float c) { float r; asm("v_max3_f32 %0, %1, %2, %3" : "=v"(r) : "v"(a), "v"(b), "v"(c)); return r; }
__device__ __forceinline__ float max2f(float a, float b) { float r; asm("v_max_f32_e32 %0, %1, %2" : "=v"(r) : "v"(a), "v"(b)); return r; }
__device__ __forceinline__ float xhalf_max(float m) { auto rr = __builtin_amdgcn_permlane32_swap(__float_as_uint(m), __float_as_uint(m), false, false); return max2f(__uint_as_float(rr[0]), __uint_as_float(rr[1])); }
__device__ __forceinline__ float xhalf_sum(float m) { auto rr = __builtin_amdgcn_permlane32_swap(__float_as_uint(m), __float_as_uint(m), false, false); return __uint_as_float(rr[0]) + __uint_as_float(rr[1]); }
__device__ __forceinline__ void attn_item(LAS unsigned char* L, const bf16_t* PROJ, bf16_t* MIXED, const float* subln, int b, int h, int qb, float lam, float one_m_li) {
    int tid = threadIdx.x; asm volatile("" : "+v"(tid)); const int lane = tid & 63, wid = __builtin_amdgcn_readfirstlane(tid >> 6), l31 = lane & 31, hi = lane >> 5;
    const int c = wid >> 2, rb = wid & 3;
    const int q0 = qb * 128; const size_t rowbase = (size_t)b * SEQ;
    bf16x8 qf[4];
    { const bf16_t* qp = PROJ + (rowbase + q0 + 32 * rb + l31) * DIN + C_DQ + h * 128 + c * 64 + 8 * hi;
#pragma unroll
      for (int s = 0; s < 4; ++s) qf[s] = *(const bf16x8*)(qp + 16 * s); }
    f32x16 o[4];
#pragma unroll
    for (int e = 0; e < 4; ++e)
#pragma unroll
        for (int r = 0; r < 16; ++r) o[e][r] = 0.f;
    float m_run = 0.f, l_run = 0.f;
    const int nt = (q0 + 128) / 64;
    const bf16_t* kg = PROJ + (rowbase + (tid >> 4)) * DIN + C_DK + h * 128 + (tid & 15) * 8;
    const bf16_t* vg = kg + (C_DV - C_DK);
    const int st_k = (tid >> 4) * AT_KP + (tid & 15) * 16, st_v = (tid >> 4) * AT_VP + (tid & 15) * 16;
    u32x4 kr[2], vr[2];
#define AT_LOAD(t) { _Pragma("unroll") for (int i_ = 0; i_ < 2; ++i_) { const size_t go_ = (size_t)((t) * 64 + 32 * i_) * DIN; kr[i_] = *(const u32x4*)(kg + go_); vr[i_] = *(const u32x4*)(vg + go_); } }
#define AT_STORE(kbf, vsl) { _Pragma("unroll") for (int i_ = 0; i_ < 2; ++i_) { *(LAS u32x4*)(L + AT_KOFF + (kbf) * AT_KB + st_k + 32 * i_ * AT_KP) = kr[i_]; *(LAS u32x4*)(L + AT_VOFF + (vsl) * AT_VB + st_v + 32 * i_ * AT_VP) = vr[i_]; } }
    AT_LOAD(0); AT_STORE(0, 0); __syncthreads();
    const int g = lane >> 4, tq = (lane & 15) >> 2, tp = lane & 3;
    const int vlane = (4 * hi + tq) * AT_VP + (16 * (g & 1) + 4 * tp) * 2;
    const int klane = l31 * AT_KP + (c * 64 + 8 * hi) * 2;
    const int qi = q0 + 32 * rb + l31;
    bf16x8 pb[4];
    f32x16 s0, s1;
#define AT_QK(t_) { const int k0 = (t_) * 64; \
        const LAS unsigned char* kb = L + AT_KOFF + ((t_) & 1) * AT_KB + klane; bf16x8 ka[4], kc[4]; \
        _Pragma("unroll") for (int s = 0; s < 4; ++s) { ka[s] = *(const LAS bf16x8*)(kb + s * 32); kc[s] = *(const LAS bf16x8*)(kb + 32 * AT_KP + s * 32); } \
        _Pragma("unroll") for (int r = 0; r < 16; ++r) { s0[r] = 0.f; s1[r] = 0.f; } \
        _Pragma("unroll") for (int s = 0; s < 4; ++s) { s0 = MFMA32(ka[s], qf[s], s0); s1 = MFMA32(kc[s], qf[s], s1); } \
        if (k0 + 63 > q0 + 32 * rb) { _Pragma("unroll") for (int r = 0; r < 16; ++r) { const int key = k0 + crow(r, hi); if (key > qi) s0[r] = -INFINITY; if (key + 32 > qi) s1[r] = -INFINITY; } } \
        asm volatile("s_nop 15\n\ts_nop 7" : "+v"(s0), "+v"(s1));     \
        { float ma = max3f(s0[0], s0[1], s1[0]), mb = max3f(s0[2], s0[3], s1[1]); ma = max3f(ma, s1[2], s1[3]); \
          _Pragma("unroll") for (int r = 4; r < 16; r += 4) { ma = max3f(ma, s0[r], s0[r + 1]); mb = max3f(mb, s0[r + 2], s0[r + 3]); ma = max3f(ma, s1[r], s1[r + 1]); mb = max3f(mb, s1[r + 2], s1[r + 3]); } \
          mx = xhalf_max(max2f(ma, mb)); } }
#define AT_LDV(dst, ks_) { _Pragma("unroll") for (int e = 0; e < 4; ++e) { dst[2 * e] = tr_read(vb + (16 * (ks_)) * AT_VP + 64 * e); dst[2 * e + 1] = tr_read(vb + (16 * (ks_) + 8) * AT_VP + 64 * e); } }
#define AT_MMV(src, ks_) { _Pragma("unroll") for (int e = 0; e < 4; ++e) o[e] = MFMA32(cat8(src[2 * e], src[2 * e + 1]), pb[ks_], o[e]); }
#define AT_EXP(S, lo_) { _Pragma("unroll") for (int r = (lo_); r < (lo_) + 8; ++r) { S[r] = fexp2(S[r] - m_new); rs += S[r]; } }
    { float mx; AT_QK(0); m_run = mx; const float m_new = mx; float rs = 0.f; AT_EXP(s0, 0); AT_EXP(s0, 8); AT_EXP(s1, 0); AT_EXP(s1, 8); l_run = rs;
      pb[0] = pack8(s0, 0); pb[1] = pack8(s0, 8); pb[2] = pack8(s1, 0); pb[3] = pack8(s1, 8); }
    int vs = 1, vsp = 0;
    AT_LOAD(1); AT_STORE(1, 1); __syncthreads();
    u32x4 kr2[2], vr2[2];
#define AT_LOADS(KR, VR, t) { _Pragma("unroll") for (int i_ = 0; i_ < 2; ++i_) { const size_t go_ = (size_t)((t) * 64 + 32 * i_) * DIN; KR[i_] = *(const u32x4*)(kg + go_); VR[i_] = *(const u32x4*)(vg + go_); } }
#define AT_STORES(KR, VR, kbf, vsl) { _Pragma("unroll") for (int i_ = 0; i_ < 2; ++i_) { *(LAS u32x4*)(L + AT_KOFF + (kbf) * AT_KB + st_k + 32 * i_ * AT_KP) = KR[i_]; *(LAS u32x4*)(L + AT_VOFF + (vsl) * AT_VB + st_v + 32 * i_ * AT_VP) = VR[i_]; } }
#define AT_ITER(t_, KS, VS, KL, VL) { \
        const int vsn = vs == 2 ? 0 : vs + 1; \
        if ((t_) + 2 < nt) AT_LOADS(KL, VL, (t_) + 2); \
        const LAS unsigned char* vb = L + AT_VOFF + vsp * AT_VB + vlane; s16x4 va[8], vn[8]; \
        AT_LDV(va, 0); AT_LDV(vn, 1);     \
        float mx; AT_QK(t_); \
        const bool need = __any(mx > m_run); \
        const float m_new = max2f(m_run, mx); \
        float rs = 0.f; \
        AT_MMV(va, 0); AT_EXP(s0, 0); AT_LDV(va, 2); \
        AT_MMV(vn, 1); AT_EXP(s0, 8); AT_LDV(vn, 3); \
        AT_MMV(va, 2); AT_EXP(s1, 0); \
        AT_MMV(vn, 3); AT_EXP(s1, 8); \
        bf16x8 pn[4]; pn[0] = pack8(s0, 0); pn[1] = pack8(s0, 8); pn[2] = pack8(s1, 0); pn[3] = pack8(s1, 8); \
        asm volatile("" : "+v"(pn[0]), "+v"(pn[1]), "+v"(pn[2]), "+v"(pn[3]), "+v"(rs)); \
        if (need) { const float alpha = fexp2(m_run - m_new); l_run *= alpha; \
            _Pragma("unroll") for (int e = 0; e < 4; ++e) _Pragma("unroll") for (int r = 0; r < 16; ++r) o[e][r] *= alpha; } \
        m_run = m_new; l_run += rs; \
        pb[0] = pn[0]; pb[1] = pn[1]; pb[2] = pn[2]; pb[3] = pn[3]; \
        if ((t_) + 1 < nt) AT_STORES(KS, VS, ((t_) + 1) & 1, vsn); \
        __syncthreads(); \
        vsp = vs; vs = vsn; }
    if (2 < nt) AT_LOADS(kr, vr, 2);
    if (wid >= 4) __builtin_amdgcn_s_setprio(1);
    for (int t = 1; t < nt; t += 2) {
        AT_ITER(t, kr, vr, kr2, vr2);
        if (t + 1 < nt) { AT_ITER(t + 1, kr2, vr2, kr, vr); }
    }
    __builtin_amdgcn_s_setprio(0);
#undef AT_LOADS
#undef AT_STORES
#undef AT_ITER
    { const LAS unsigned char* vb = L + AT_VOFF + vsp * AT_VB + vlane; s16x4 va[8], vn[8];
      AT_LDV(va, 0); AT_LDV(vn, 1); AT_MMV(va, 0); AT_LDV(va, 2); AT_MMV(vn, 1); AT_LDV(vn, 3); AT_MMV(va, 2); AT_MMV(vn, 3); }
    __syncthreads();
#undef AT_LOAD
#undef AT_STORE
#undef AT_QK
#undef AT_LDV
#undef AT_MMV
#undef AT_EXP
    u32x4 gwv[4];
    { const bf16_t* gp_ = PROJ + (rowbase + q0 + (tid >> 2)) * DIN + C_DG + h * 128 + 32 * (tid & 3);
#pragma unroll
      for (int j = 0; j < 4; ++j) gwv[j] = *(const u32x4*)(gp_ + 8 * j); }
    l_run = xhalf_sum(l_run);
    const float sc = (c == 0 ? 1.f : -lam) / l_run;
#pragma unroll
    for (int e = 0; e < 4; ++e)
#pragma unroll
        for (int r = 0; r < 16; ++r) o[e][r] *= sc;
    LAS float* X = (LAS float*)(L + AT_XOFF); LAS float* E = (LAS float*)(L + AT_EOFF);
    if (c == 1) {
#pragma unroll
        for (int e = 0; e < 4; ++e)
#pragma unroll
            for (int r = 0; r < 16; ++r) X[((e * 16 + r) * 4 + rb) * 64 + lane] = o[e][r];
    }
    __syncthreads();
    if (c == 0) {
#pragma unroll
        for (int e = 0; e < 4; ++e)
#pragma unroll
            for (int r = 0; r < 16; ++r) o[e][r] += X[((e * 16 + r) * 4 + rb) * 64 + lane];
#pragma unroll
        for (int e = 0; e < 4; ++e)
#pragma unroll
            for (int r4 = 0; r4 < 4; ++r4) *(LAS f32x4*)(E + (32 * rb + l31) * E_PITCH + 32 * e + 8 * r4 + 4 * hi) = (f32x4){o[e][4 * r4], o[e][4 * r4 + 1], o[e][4 * r4 + 2], o[e][4 * r4 + 3]};
    }
    __syncthreads();
    { const int row = tid >> 2, qtr = tid & 3; const LAS float* er = E + row * E_PITCH + 32 * qtr; f32x4 v[8]; float ss = 0.f;
#pragma unroll
      for (int j = 0; j < 8; ++j) { v[j] = *(const LAS f32x4*)(er + 4 * j); ss += (v[j][0] * v[j][0] + v[j][1] * v[j][1]) + (v[j][2] * v[j][2] + v[j][3] * v[j][3]); }
      ss += __shfl_xor(ss, 1); ss += __shfl_xor(ss, 2);
      const float rstd = one_m_li / sqrtf(ss * (1.f / 128.f) + EPS);
      const size_t m = rowbase + q0 + row; const bf16_t* gp = PROJ + m * DIN + C_DG + h * 128 + 32 * qtr; bf16_t* op = MIXED + m * 2048 + 768 + h * 128 + 32 * qtr; const float* sg = subln + 32 * qtr;
#pragma unroll
      for (int j = 0; j < 4; ++j) { const u32x4 gw = gwv[j]; const f32x4 a = v[2 * j], bq = v[2 * j + 1]; const f32x4 g0 = *(const f32x4*)(sg + 8 * j), g1 = *(const f32x4*)(sg + 8 * j + 4);
          u32x4 w; w.x = cvtpk(a[0] * rstd * g0[0] * silu(bflo(gw.x)), a[1] * rstd * g0[1] * silu(bfhi(gw.x))); w.y = cvtpk(a[2] * rstd * g0[2] * silu(bflo(gw.y)), a[3] * rstd * g0[3] * silu(bfhi(gw.y)));
          w.z = cvtpk(bq[0] * rstd * g1[0] * silu(bflo(gw.z)), bq[1] * rstd * g1[1] * silu(bfhi(gw.z))); w.w = cvtpk(bq[2] * rstd * g1[2] * silu(bflo(gw.w)), bq[3] * rstd * g1[3] * silu(bfhi(gw.w)));
          *(u32x4*)(op + 8 * j) = w; }
    }
    __syncthreads();
}

constexpr int RT_P = 320, RK_P = 272;
__device__ __forceinline__ void ret_kv_phase(LAS unsigned char* L, const bf16_t* PROJ, float* KV, int bid, int G) {
    int tid = threadIdx.x; asm volatile("" : "+v"(tid)); const int lane = tid & 63, wid = __builtin_amdgcn_readfirstlane(tid >> 6), l31 = lane & 31, hi = lane >> 5;
    LAS unsigned char* Kb = L; LAS unsigned char* Vb = L + 128 * RT_P;
    u32x4 rk[4], rv[4];
#define RK_LOAD(it_) { const int h_ = (it_) % 6, n_ = ((it_) / 6) % 64, b_ = (it_) / 384; const size_t rb_ = (size_t)b_ * SEQ + (size_t)n_ * 128; \
        _Pragma("unroll") for (int i_ = 0; i_ < 4; ++i_) { const int id = tid + 512 * i_, row = id >> 4, ch = id & 15; const bf16_t* src = PROJ + (rb_ + row) * DIN + h_ * 128 + ch * 8; \
            rk[i_] = *(const u32x4*)(src + C_RK); rv[i_] = *(const u32x4*)(src + C_RV); } }
    int it = bid;
    if (it < 768) RK_LOAD(it);
    for (; it < 768; it += G) {
        const int h = it % 6, n = (it / 6) % 64, b = it / 384;
        const float log2g = ret_log2g(h);
#pragma unroll
        for (int i = 0; i < 4; ++i) { const int id = tid + 512 * i, row = id >> 4, ch = id & 15;
            const u32x4 kv_ = rk[i];
            const float w = fexp2((float)(127 - row) * log2g);
            u32x4 ks; ks.x = cvtpk(bflo(kv_.x) * w, bfhi(kv_.x) * w); ks.y = cvtpk(bflo(kv_.y) * w, bfhi(kv_.y) * w); ks.z = cvtpk(bflo(kv_.z) * w, bfhi(kv_.z) * w); ks.w = cvtpk(bflo(kv_.w) * w, bfhi(kv_.w) * w);
            *(LAS u32x4*)(Kb + row * RT_P + ch * 16) = ks; *(LAS u32x4*)(Vb + row * RT_P + ch * 16) = rv[i]; }
        __syncthreads();
        if (it + G < 768) RK_LOAD(it + G);
        const int eb = wid >> 1, db0 = 2 * (wid & 1);
        const int g = lane >> 4, tq = (lane & 15) >> 2, tp = lane & 3;
        const int lanepart = (8 * hi + tq) * RT_P + (16 * (g & 1) + 4 * tp) * 2;
        f32x16 acc[2];
#pragma unroll
        for (int j = 0; j < 2; ++j)
#pragma unroll
            for (int r = 0; r < 16; ++r) acc[j][r] = 0.f;
#pragma unroll
        for (int s = 0; s < 8; ++s) {
            const LAS unsigned char* va = Vb + (16 * s) * RT_P + lanepart + 64 * eb;
            const bf16x8 A = cat8(tr_read(va), tr_read(va + 4 * RT_P));
#pragma unroll
            for (int j = 0; j < 2; ++j) { const LAS unsigned char* ka = Kb + (16 * s) * RT_P + lanepart + 64 * (db0 + j); const bf16x8 B = cat8(tr_read(ka), tr_read(ka + 4 * RT_P)); acc[j] = MFMA32(A, B, acc[j]); }
        }
        float* dst = KV + ((size_t)((b * 6 + h) * 64 + n)) * 16384;
#pragma unroll
        for (int j = 0; j < 2; ++j)
#pragma unroll
            for (int r = 0; r < 16; ++r) dst[(32 * eb + crow(r, hi)) * 128 + 32 * (db0 + j) + l31] = acc[j][r];
        __syncthreads();
    }
#undef RK_LOAD
}
__device__ __forceinline__ void ret_out_phase(LAS unsigned char* L, const bf16_t* PROJ, const bf16_t* SP, bf16_t* MIXED, int bid, int G) {
    int tid = threadIdx.x; asm volatile("" : "+v"(tid)); const int lane = tid & 63, wid = __builtin_amdgcn_readfirstlane(tid >> 6), l31 = lane & 31, hi = lane >> 5;
    LAS unsigned char* Kb = L; LAS unsigned char* Sb = L + 128 * RK_P; LAS unsigned char* Vb = L + 2 * 128 * RK_P; LAS unsigned char* Qb = Vb + 128 * RT_P;
    u32x4 rk[4], rv[4], rs_[4], rq[4];
#define RO_LOAD(it_) { const int h_ = (it_) % 6, n_ = ((it_) / 6) % 64, b_ = (it_) / 384; const size_t rb_ = (size_t)b_ * SEQ + (size_t)n_ * 128; \
        const bf16_t* sp_ = SP + ((size_t)((b_ * 6 + h_) * 64 + n_)) * 16384; \
        _Pragma("unroll") for (int i_ = 0; i_ < 4; ++i_) { const int id = tid + 512 * i_, row = id >> 4, ch = id & 15; const bf16_t* src = PROJ + (rb_ + row) * DIN + h_ * 128 + ch * 8; \
            rk[i_] = *(const u32x4*)(src + C_RK); rv[i_] = *(const u32x4*)(src + C_RV); rq[i_] = *(const u32x4*)(src + C_RQ); rs_[i_] = *(const u32x4*)(sp_ + row * 128 + ch * 8); } }
    int it = bid;
    if (it < 768) RO_LOAD(it);
    for (; it < 768; it += G) {
        const int h = it % 6, n = (it / 6) % 64, b = it / 384;
        const float log2g = ret_log2g(h);
        const size_t rowbase = (size_t)b * SEQ + (size_t)n * 128;
#pragma unroll
        for (int i = 0; i < 4; ++i) { const int id = tid + 512 * i, row = id >> 4, ch = id & 15;
            *(LAS u32x4*)(Kb + row * RK_P + ch * 16) = rk[i]; *(LAS u32x4*)(Vb + row * RT_P + ch * 16) = rv[i];
            *(LAS u32x4*)(Sb + row * RK_P + ch * 16) = rs_[i]; *(LAS u32x4*)(Qb + row * RK_P + ch * 16) = rq[i]; }
        __syncthreads();
        if (it + G < 768) RO_LOAD(it + G);
        u32x4 gwv[4];
        { const int row = tid >> 2, qtr = tid & 3; const bf16_t* gp = PROJ + (rowbase + row) * DIN + C_RG + h * 128 + 32 * qtr;
#pragma unroll
          for (int j = 0; j < 4; ++j) gwv[j] = *(const u32x4*)(gp + 8 * j); }
        const int ib = wid & 3, eh = wid >> 2;
        bf16x8 qf[8];
#pragma unroll
        for (int s = 0; s < 8; ++s) qf[s] = *(const LAS bf16x8*)(Qb + (32 * ib + l31) * RK_P + (16 * s + 8 * hi) * 2);
        f32x16 acc[2];
#pragma unroll
        for (int j = 0; j < 2; ++j)
#pragma unroll
            for (int r = 0; r < 16; ++r) acc[j][r] = 0.f;
#pragma unroll
        for (int s = 0; s < 8; ++s)
#pragma unroll
            for (int j = 0; j < 2; ++j) { const bf16x8 A = *(const LAS bf16x8*)(Sb + (32 * (2 * eh + j) + l31) * RK_P + (16 * s + 8 * hi) * 2); acc[j] = MFMA32(A, qf[s], acc[j]); }
        const int iloc = 32 * ib + l31;
        { const float qw = fexp2((float)(iloc + 1) * log2g);
#pragma unroll
          for (int j = 0; j < 2; ++j)
#pragma unroll
              for (int r = 0; r < 16; ++r) acc[j][r] *= qw; }
        const int g = lane >> 4, tq = (lane & 15) >> 2, tp = lane & 3;
        const int vlane = (4 * hi + tq) * RT_P + (16 * (g & 1) + 4 * tp) * 2;
        for (int jb = 0; jb <= ib; ++jb) {
            f32x16 S;
#pragma unroll
            for (int r = 0; r < 16; ++r) S[r] = 0.f;
#pragma unroll
            for (int s = 0; s < 8; ++s) { const bf16x8 A = *(const LAS bf16x8*)(Kb + (32 * jb + l31) * RK_P + (16 * s + 8 * hi) * 2); S = MFMA32(A, qf[s], S); }
#pragma unroll
            for (int r = 0; r < 16; ++r) { const int d = iloc - (32 * jb + crow(r, hi)); S[r] = d >= 0 ? S[r] * fexp2((float)d * log2g) : 0.f; }
            bf16x8 pb[2]; pb[0] = pack8(S, 0); pb[1] = pack8(S, 8);
#pragma unroll
            for (int t2 = 0; t2 < 2; ++t2)
#pragma unroll
                for (int j = 0; j < 2; ++j) { const LAS unsigned char* va = Vb + (32 * jb + 16 * t2) * RT_P + vlane + 64 * (2 * eh + j); acc[j] = MFMA32(cat8(tr_read(va), tr_read(va + 8 * RT_P)), pb[t2], acc[j]); }
        }
        __syncthreads();
        LAS float* E = (LAS float*)L;
#pragma unroll
        for (int j = 0; j < 2; ++j)
#pragma unroll
            for (int r4 = 0; r4 < 4; ++r4) *(LAS f32x4*)(E + (32 * ib + l31) * E_PITCH + 32 * (2 * eh + j) + 8 * r4 + 4 * hi) = (f32x4){acc[j][4 * r4], acc[j][4 * r4 + 1], acc[j][4 * r4 + 2], acc[j][4 * r4 + 3]};
        __syncthreads();
        { const int row = tid >> 2, qtr = tid & 3; const LAS float* er = E + row * E_PITCH + 32 * qtr; f32x4 v[8]; float ss = 0.f;
#pragma unroll
          for (int j = 0; j < 8; ++j) { v[j] = *(const LAS f32x4*)(er + 4 * j); ss += (v[j][0] * v[j][0] + v[j][1] * v[j][1]) + (v[j][2] * v[j][2] + v[j][3] * v[j][3]); }
          ss += __shfl_xor(ss, 1); ss += __shfl_xor(ss, 2);
          const float rstd = 1.f / sqrtf(ss * (1.f / 128.f) + EPS);
          bf16_t* op = MIXED + (rowbase + row) * 2048 + h * 128 + 32 * qtr;
#pragma unroll
          for (int j = 0; j < 4; ++j) { const u32x4 gw = gwv[j]; const f32x4 a = v[2 * j], bq = v[2 * j + 1];
              u32x4 w; w.x = cvtpk(a[0] * rstd * silu(bflo(gw.x)), a[1] * rstd * silu(bfhi(gw.x))); w.y = cvtpk(a[2] * rstd * silu(bflo(gw.y)), a[3] * rstd * silu(bfhi(gw.y)));
              w.z = cvtpk(bq[0] * rstd * silu(bflo(gw.z)), bq[1] * rstd * silu(bfhi(gw.z))); w.w = cvtpk(bq[2] * rstd * silu(bflo(gw.w)), bq[3] * rstd * silu(bfhi(gw.w)));
              *(u32x4*)(op + 8 * j) = w; }
        }
        __syncthreads();
    }
#undef RO_LOAD
}
constexpr int LR_XC = 0, LR_XCB = 49664, LR_GA = 76288, LR_LX = 76288, LR_XP = 97, LR_BP = 208;
constexpr int LR_CST = 125952;
__device__ __forceinline__ void lru_phase(LAS unsigned char* L, const Params& p, int layer, const bf16_t* PROJ, const bf16_t* LW, const float* C8, unsigned* HA, float* HEND, float* AEND, int bid, int G) {
    int tid = threadIdx.x; asm volatile("" : "+v"(tid)); const int lane = tid & 63, wid = __builtin_amdgcn_readfirstlane(tid >> 6), l31 = lane & 31, hi = lane >> 5;
    LAS float* XC = (LAS float*)(L + LR_XC); LAS unsigned char* XCB = L + LR_XCB; LAS float* GA = (LAS float*)(L + LR_GA); LAS unsigned char* LX = L + LR_LX; LAS float* CST = (LAS float*)(L + LR_CST);
    u32x4 lxr[4];
#define LRU_LOAD(it_) { const int jb_ = (it_) & 7, n_ = ((it_) >> 3) & 63, b_ = (it_) >> 9; const size_t rb_ = (size_t)b_ * SEQ + (size_t)n_ * 128; \
        _Pragma("unroll") for (int i_ = 0; i_ < 4; ++i_) { const int id = tid + 512 * i_; const int row = id / 12, ch = id - row * 12; lxr[i_] = (u32x4){0u, 0u, 0u, 0u}; \
            if (id < 131 * 12 && (n_ > 0 || row >= 3)) lxr[i_] = *(const u32x4*)(PROJ + (rb_ + row - 3) * DIN + C_LX + 96 * jb_ + 8 * ch); } }
    int it = bid;
    if (it < 1024) LRU_LOAD(it);
    for (; it < 1024; it += G) {
        const int jb = it & 7, n = (it >> 3) & 63, b = it >> 9;
        const size_t rowbase = (size_t)b * SEQ + (size_t)n * 128;
#pragma unroll
        for (int i = 0; i < 4; ++i) { const int id = tid + 512 * i; const int row = id / 12, ch = id - row * 12; if (id < 131 * 12) *(LAS u32x4*)(LX + row * 192 + ch * 16) = lxr[i]; }
        for (int e = tid; e < 768; e += 512) { const int a = e / 96, c = e - a * 96; float v;
            if (a == 0) v = p.ba[layer * 768 + 96 * jb + c]; else if (a == 1) v = p.bx[layer * 768 + 96 * jb + c]; else if (a == 2) v = C8[layer * 768 + 96 * jb + c];
            else if (a < 7) v = p.conv_w[(size_t)layer * 4 * 768 + (a - 3) * 768 + 96 * jb + c]; else v = p.conv_b[layer * 768 + 96 * jb + c];
            CST[e] = v; }
        const int tb = wid & 3, half = wid >> 2; const int cb0 = half == 0 ? 0 : 2, cb1 = half == 0 ? 2 : 3;
        const bf16_t* WA = LW + ((size_t)((layer * 2 + 0) * 8 + jb)) * 9216; const bf16_t* WX = LW + ((size_t)((layer * 2 + 1) * 8 + jb)) * 9216;
        bf16x8 fa[6], fx[6];
#pragma unroll
        for (int s = 0; s < 6; ++s) { fa[s] = *(const bf16x8*)(WA + (32 * cb0 + l31) * 96 + 16 * s + 8 * hi); fx[s] = *(const bf16x8*)(WX + (32 * cb0 + l31) * 96 + 16 * s + 8 * hi); }
        __syncthreads();
        if (it + G < 1024) LRU_LOAD(it + G);
        if (tid < 480) { const int c = tid % 96, grp = tid / 96; const int t0 = grp * 26, t1 = t0 + 26 < 128 ? t0 + 26 : 128;
            const float w0 = CST[3 * 96 + c], w1 = CST[4 * 96 + c], w2 = CST[5 * 96 + c], w3 = CST[6 * 96 + c], bs = CST[7 * 96 + c];
            const LAS unsigned short* lx = (const LAS unsigned short*)(LX + c * 2);
            float x0 = __uint_as_float((unsigned)lx[(t0 + 0) * 96] << 16), x1 = __uint_as_float((unsigned)lx[(t0 + 1) * 96] << 16), x2 = __uint_as_float((unsigned)lx[(t0 + 2) * 96] << 16);
            for (int t = t0; t < t1; ++t) { const float x3 = __uint_as_float((unsigned)lx[(t + 3) * 96] << 16);
                const float acc = bs + x0 * w0 + x1 * w1 + x2 * w2 + x3 * w3;
                XC[t * LR_XP + c] = acc; *(LAS unsigned short*)(XCB + t * LR_BP + c * 2) = (unsigned short)(cvtpk(acc, 0.f) & 0xffffu);
                x0 = x1; x1 = x2; x2 = x3; } }
        __syncthreads();
        { const int tok = 32 * tb + l31;
          for (int cbk = cb0; cbk < cb1; ++cbk) {
              f32x16 aR, aI;
#pragma unroll
              for (int r = 0; r < 16; ++r) { aR[r] = 0.f; aI[r] = 0.f; }
              if (cbk != cb0) {
#pragma unroll
                  for (int s = 0; s < 6; ++s) { fa[s] = *(const bf16x8*)(WA + (32 * cbk + l31) * 96 + 16 * s + 8 * hi); fx[s] = *(const bf16x8*)(WX + (32 * cbk + l31) * 96 + 16 * s + 8 * hi); }
              }
#pragma unroll
              for (int s = 0; s < 6; ++s) { const bf16x8 B = *(const LAS bf16x8*)(XCB + tok * LR_BP + (16 * s + 8 * hi) * 2); aR = MFMA32(fa[s], B, aR); aI = MFMA32(fx[s], B, aI); }
#pragma unroll
              for (int r = 0; r < 16; ++r) { const int cc = 32 * cbk + crow(r, hi);
                  const float rr = sigm(aR[r] + CST[cc]), ii = sigm(aI[r] + CST[96 + cc]);
                  const float log_a = rr * CST[192 + cc]; const float a = __expf(log_a); const float x2 = 2.f * log_a;
                  const float m1s = -x2 * (1.f + x2 * (0.5f + x2 * (0.16666667f + x2 * (0.041666668f + x2 * 0.008333334f))));
                  const float m1 = x2 < -0.25f ? 1.f - a * a : m1s;
                  const float mult = __builtin_amdgcn_sqrtf(m1);
                  const float xcv = XC[tok * LR_XP + cc];
                  GA[tok * LR_XP + cc] = a; XC[tok * LR_XP + cc] = mult * (ii * xcv); }
          }
        }
        __syncthreads();
        LAS float* SEGA = (LAS float*)XCB; LAS float* SEGH = SEGA + 4 * 96;
        const int sc_c = tid % 96, seg = tid / 96;
        float av[32], bv[32];
        if (tid < 384) {
#pragma unroll
            for (int t = 0; t < 32; ++t) { av[t] = GA[(32 * seg + t) * LR_XP + sc_c]; bv[t] = XC[(32 * seg + t) * LR_XP + sc_c]; }
            float A = 1.f, H = 0.f;
#pragma unroll
            for (int t = 0; t < 32; ++t) { H = av[t] * H + bv[t]; A *= av[t]; av[t] = A; bv[t] = H; }
            SEGA[seg * 96 + sc_c] = A; SEGH[seg * 96 + sc_c] = H; }
        __syncthreads();
        if (tid < 384) { float Hin = 0.f, Ain = 1.f;
            for (int s2 = 0; s2 < seg; ++s2) { Hin = SEGA[s2 * 96 + sc_c] * Hin + SEGH[s2 * 96 + sc_c]; Ain *= SEGA[s2 * 96 + sc_c]; }
            unsigned* dst = HA + (rowbase + 32 * seg) * 768 + 96 * jb + sc_c;
#pragma unroll
            for (int t = 0; t < 32; ++t) { const float Hf = bv[t] + av[t] * Hin, Af = av[t] * Ain; dst[(size_t)t * 768] = cvtpk(Hf, Af);
                if (t == 31 && seg == 3) { HEND[(size_t)(b * 64 + n) * 768 + 96 * jb + sc_c] = Hf; AEND[(size_t)(b * 64 + n) * 768 + 96 * jb + sc_c] = Af; } } }
        __syncthreads();
    }
#undef LRU_LOAD
}

#define XB_TMO      128
#define XB_XCNT(j)  (256  + 64 * (j))
#define XB_XSUB(j)  (1280 + 64 * (j))
#define XB_XGEN(j)  (2304 + 64 * (j))
#define XB_TOP      3328
#define XB_TOPGEN   3392
#define XCD_BAR_WORDS 3456
#define XB_SPIN_CAP (1u << 18)

__device__ __forceinline__ unsigned xb_ld(unsigned* p)              { return __hip_atomic_load(p, __ATOMIC_RELAXED, __HIP_MEMORY_SCOPE_AGENT); }
__device__ __forceinline__ unsigned xb_add(unsigned* p, unsigned v) { return __hip_atomic_fetch_add(p, v, __ATOMIC_RELAXED, __HIP_MEMORY_SCOPE_AGENT); }
__device__ __forceinline__ unsigned xb_xcc_id() { return (unsigned)__builtin_amdgcn_s_getreg((3 << 11) | 20) & 0xFu; }
#define XB_SPIN(cond, bar) do { unsigned _sp = 0; while (cond) { __builtin_amdgcn_s_sleep(1); \
    if ((++_sp & 255u) == 0u) { if (xb_ld(&(bar)[XB_TMO])) break; if (_sp > XB_SPIN_CAP) { atomicAdd(&(bar)[XB_TMO], 1u); break; } } } } while (0)

struct XcdBarrier {
    unsigned* bar; unsigned x;
    volatile LAS unsigned* st;
};

__device__ __forceinline__ XcdBarrier xcd_barrier_post(unsigned* bar, volatile LAS unsigned* st) {
    XcdBarrier b; b.bar = bar; b.x = xb_xcc_id(); b.st = st;
    if (threadIdx.x == 0) (void)xb_add(&bar[XB_XCNT(b.x)], 1u);
    return b;
}
__device__ __forceinline__ void xcd_barrier_complete(unsigned* bar, unsigned x, unsigned& nloc, unsigned& nx) {
    const unsigned G = gridDim.x * gridDim.y * gridDim.z;
    unsigned sum, cnt, mine, sp = 0u;
    for (;;) {
        sum = 0u; cnt = 0u; mine = 0u;
#pragma unroll
        for (unsigned j = 0; j < 16; ++j) { const unsigned c = xb_ld(&bar[XB_XCNT(j)]); sum += c; cnt += (c > 0u) ? 1u : 0u; mine = (j == x) ? c : mine; }
        if (sum == G) break;
        __builtin_amdgcn_s_sleep(1);
        if ((++sp & 255u) == 0u) { if (xb_ld(&bar[XB_TMO])) break; if (sp > XB_SPIN_CAP) { atomicAdd(&bar[XB_TMO], 1u); break; } }
    }
    nloc = mine > 0u ? mine : 1u; nx = cnt > 0u ? cnt : 1u;
}

__device__ __forceinline__ void xcd_barrier(const XcdBarrier& b) {
    asm volatile("s_waitcnt vmcnt(0)" ::: "memory");
    __syncthreads();
    if (threadIdx.x == 0) {
        unsigned* bar = b.bar;
        __builtin_amdgcn_s_waitcnt(0);
        unsigned nloc = b.st[0], nx = b.st[1];
        if (nloc == 0u) { xcd_barrier_complete(bar, b.x, nloc, nx); b.st[0] = nloc; b.st[1] = nx; }
        const unsigned old = xb_add(&bar[XB_XSUB(b.x)], 1u);
        const unsigned gen = old / nloc;
        if (old + 1u == (gen + 1u) * nloc) {
            __builtin_amdgcn_fence(__ATOMIC_RELEASE, "agent");
            asm volatile("s_waitcnt vmcnt(0)" ::: "memory");
            const unsigned og = xb_add(&bar[XB_TOP], 1u);
            const unsigned tg = og / nx;
            if (og + 1u == (tg + 1u) * nx) xb_add(&bar[XB_TOPGEN], 1u);
            else XB_SPIN(xb_ld(&bar[XB_TOPGEN]) == tg, bar);
            __builtin_amdgcn_fence(__ATOMIC_ACQUIRE, "agent");
            xb_add(&bar[XB_XGEN(b.x)], 1u);
            asm volatile("s_waitcnt vmcnt(0)" ::: "memory");
        } else {
            XB_SPIN(xb_ld(&bar[XB_XGEN(b.x)]) == gen, bar);
            __builtin_amdgcn_fence(__ATOMIC_ACQUIRE, "agent");
            asm volatile("s_waitcnt vmcnt(0)" ::: "memory");
        }
    }
    __syncthreads();
}

#ifndef REP_P0
#define REP_P0 1
#endif
#ifndef REP_G1
#define REP_G1 1
#endif
#ifndef REP_AT
#define REP_AT 1
#endif
#ifndef REP_RK
#define REP_RK 1
#endif
#ifndef REP_LR
#define REP_LR 1
#endif
#ifndef REP_SC
#define REP_SC 1
#endif
#ifndef REP_RO
#define REP_RO 1
#endif
#ifndef REP_G2
#define REP_G2 1
#endif
#ifndef REP_FN
#define REP_FN 1
#endif
__global__ void __launch_bounds__(512) mega_fwd(Params p) {
    extern __shared__ __attribute__((aligned(16))) unsigned char lds_raw[];
    LAS unsigned char* L = (LAS unsigned char*)lds_raw;
    cg::grid_group grid = cg::this_grid();
    unsigned char* ws = p.ws;
    const int G = gridDim.x, bid = blockIdx.x, NGW = G * 8, NT = G * 512;
#define TIDS int tid = threadIdx.x; asm volatile("" : "+v"(tid)); const int lane = tid & 63, wave = tid >> 6, gw = bid * 8 + wave, gt = bid * 512 + tid; (void)lane; (void)gw; (void)gt;
    bf16_t* XB = (bf16_t*)(ws + WS_XB); bf16_t* MIXED = (bf16_t*)p.out;     bf16_t* PROJ = (bf16_t*)(ws + WS_PROJ); bf16_t* Y = (bf16_t*)(ws + WS_Y);
    float* KV = (float*)(ws + WS_KV); bf16_t* SP = (bf16_t*)(ws + WS_SP); unsigned* HA = (unsigned*)(ws + WS_HL);
    float* HEND = (float*)(ws + WS_HEND); float* AEND = (float*)(ws + WS_AEND); float* CARRY = (float*)(ws + WS_CARRY);
    float* RSTD = (float*)(ws + WS_RSTD); const bf16_t* LW = (const bf16_t*)(ws + WS_LRUW);
    const int lo = p.ph_lo, hi = p.ph_hi;
    volatile LAS unsigned* bst = (volatile LAS unsigned*)(L + LDS_BARST);
    if (threadIdx.x < 8) bst[threadIdx.x] = 0u;
    __syncthreads();
    XcdBarrier xbar; xbar.bar = (unsigned*)(ws + WS_BAR); xbar.x = 0; xbar.st = bst;
    if (hi - lo > 1) xbar = xcd_barrier_post((unsigned*)(ws + WS_BAR), bst);
    unsigned* cen = (unsigned*)(ws + WS_BAR) + 3584;
    if (threadIdx.x == 0 && hi - lo > 1) { const unsigned xcc = xb_xcc_id(); bst[2] = xcc; bst[3] = xb_add(&cen[xcc], 1u); }
#define IN(k) (lo <= (k) && (k) < hi)
#define SEAM(k) do { if (IN(k) && IN((k) + 1)) { if (p.ph_hi > 1000) grid.sync(); else xcd_barrier(xbar); } } while (0)
    if (IN(0)) { for (int rep_ = 0; rep_ < REP_P0; ++rep_) phase0(p, L); }
    SEAM(0);
    int vid = bid;
    if (hi - lo > 1) {
        if (threadIdx.x == 0) { bool ok = (G % 8) == 0; for (int j = 0; j < 16; ++j) { const unsigned cj = xb_ld(&cen[j]); ok = ok && (cj == (j < 8 ? (unsigned)(G / 8) : 0u)); }
            bst[4] = ok ? (bst[2] + 8u * bst[3]) : (unsigned)bid; }
        __syncthreads();
        vid = (int)bst[4];
    }
    vid = __builtin_amdgcn_readfirstlane(vid);
#pragma unroll 1
    for (int layer = 0; layer < 2; ++layer) {
        const int kb_ = 1 + 6 * layer;
        float* SSQ = (float*)(ws + WS_SSQ) + layer * M;
        if (IN(kb_ + 0)) for (int rep_ = 0; rep_ < REP_G1; ++rep_) {
            pg8::Gemm g{XB, (const bf16_t*)(ws + WS_WIN) + (size_t)layer * DIN * 2048, M, DIN, 2048}; pg8::StaticOrder S; S.init(M, DIN, G, vid);
            pg8::EpiProj E{PROJ, RSTD, (const float*)(ws + WS_COSR), (const float*)(ws + WS_SINR), (const float*)(ws + WS_COSD), (const float*)(ws + WS_SIND)};
            pg8::gemm_phase<pg8::EpiProj, pg8::StaticOrder, true, true>(L, g, S, E);
        }
        SEAM(kb_ + 0);
        if (IN(kb_ + 1)) {
            float d1 = 0.f, d2 = 0.f;
            for (int i = 0; i < 64; ++i) { d1 += p.lq1[layer * 64 + i] * p.lk1[layer * 64 + i]; d2 += p.lq2[layer * 64 + i] * p.lk2[layer * 64 + i]; }
            const float lam_init = 0.8f - 0.6f * expf(-0.3f * (float)layer);
            const float lam = expf(d1) - expf(d2) + lam_init;
            for (int rep_ = 0; rep_ < REP_AT; ++rep_) for (int pi = vid; pi < 256; pi += G) { const int bh = pi & 7, pp = pi >> 3;
                attn_item(L, PROJ, MIXED, p.subln_g + layer * 128, bh >> 2, bh & 3, 63 - pp, lam, 1.f - lam_init);
                attn_item(L, PROJ, MIXED, p.subln_g + layer * 128, bh >> 2, bh & 3, pp, lam, 1.f - lam_init); }
            ret_kv_phase(L, PROJ, KV, bid, G);
            for (int rep_ = 0; rep_ < REP_LR; ++rep_) lru_phase(L, p, layer, PROJ, LW, (const float*)(ws + WS_C8), HA, HEND, AEND, bid, G);
        }
        SEAM(kb_ + 1);
        if (IN(kb_ + 2)) for (int rep_ = 0; rep_ < REP_SC; ++rep_) {
            TIDS
            typedef float f32x2 __attribute__((ext_vector_type(2)));
            for (int idx = gt; idx < 12 * 8192; idx += NT) { const int bh = idx >> 13, ed = (idx & 8191) * 2; const float cd = fexp2(128.f * ret_log2g(bh % 6));
                const float* src = KV + (size_t)bh * 64 * 16384 + ed; bf16_t* dst = SP + (size_t)bh * 64 * 16384 + ed; float st0 = 0.f, st1 = 0.f;
                for (int n0 = 0; n0 < 64; n0 += 8) { f32x2 v[8];
#pragma unroll
                    for (int i = 0; i < 8; ++i) v[i] = __builtin_nontemporal_load((const f32x2*)(src + (size_t)(n0 + i) * 16384));
#pragma unroll
                    for (int i = 0; i < 8; ++i) { *(unsigned*)(dst + (size_t)(n0 + i) * 16384) = cvtpk(st0, st1); st0 = st0 * cd + v[i][0]; st1 = st1 * cd + v[i][1]; } } }
            for (int idx = gt; idx < 2 * 768; idx += NT) { const int b = idx / 768, c = idx - b * 768; float H = 0.f;
                for (int n0 = 0; n0 < 64; n0 += 8) { float a[8], hh[8];
#pragma unroll
                    for (int i = 0; i < 8; ++i) { a[i] = AEND[(size_t)(b * 64 + n0 + i) * 768 + c]; hh[i] = HEND[(size_t)(b * 64 + n0 + i) * 768 + c]; }
#pragma unroll
                    for (int i = 0; i < 8; ++i) { CARRY[(size_t)(b * 64 + n0 + i) * 768 + c] = H; H = a[i] * H + hh[i]; } } }
        }
        SEAM(kb_ + 2);
        if (IN(kb_ + 3)) for (int rep_ = 0; rep_ < REP_RO; ++rep_) {
            TIDS
            ret_out_phase(L, PROJ, SP, MIXED, bid, G);
            for (int idx = gt; idx < M * 96; idx += NT) { const int m = idx / 96, c = (idx - m * 96) * 8; const int bn = m >> 7;
                const u32x4 h0 = __builtin_nontemporal_load((const u32x4*)(HA + (size_t)m * 768 + c)), h1 = __builtin_nontemporal_load((const u32x4*)(HA + (size_t)m * 768 + c + 4)), lg = __builtin_nontemporal_load((const u32x4*)(PROJ + (size_t)m * DIN + C_LG + c));
                const f32x4 c0 = *(const f32x4*)(CARRY + (size_t)bn * 768 + c), c1 = *(const f32x4*)(CARRY + (size_t)bn * 768 + c + 4);
                u32x4 w;
                w.x = cvtpk((bflo(h0.x) + bfhi(h0.x) * c0[0]) * silu(bflo(lg.x)), (bflo(h0.y) + bfhi(h0.y) * c0[1]) * silu(bfhi(lg.x)));
                w.y = cvtpk((bflo(h0.z) + bfhi(h0.z) * c0[2]) * silu(bflo(lg.y)), (bflo(h0.w) + bfhi(h0.w) * c0[3]) * silu(bfhi(lg.y)));
                w.z = cvtpk((bflo(h1.x) + bfhi(h1.x) * c1[0]) * silu(bflo(lg.z)), (bflo(h1.y) + bfhi(h1.y) * c1[1]) * silu(bfhi(lg.z)));
                w.w = cvtpk((bflo(h1.z) + bfhi(h1.z) * c1[2]) * silu(bflo(lg.w)), (bflo(h1.w) + bfhi(h1.w) * c1[3]) * silu(bfhi(lg.w)));
                *(u32x4*)(MIXED + (size_t)m * 2048 + 1280 + c) = w; }
        }
        SEAM(kb_ + 3);
        if (IN(kb_ + 4)) for (int rep_ = 0; rep_ < REP_G2; ++rep_) {
            pg8::Gemm g{MIXED, (const bf16_t*)(ws + WS_WOUT) + (size_t)layer * 2048 * 2048, M, 2048, 2048}; pg8::StaticOrder S; S.init(M, 2048, G, vid);
            pg8::EpiY E{Y, rep_ == 0 ? SSQ : (float*)(ws + WS_KV)};
            pg8::gemm_phase<pg8::EpiY, pg8::StaticOrder, true, true>(L, g, S, E);
        }
        SEAM(kb_ + 4);
        if (IN(kb_ + 5)) for (int rep_ = 0; rep_ < REP_FN; ++rep_) {
            TIDS
            const float* pg = p.post_g + layer * 2048;
            for (int m = gw; m < M; m += NGW) {
                const float rs = 1.f / sqrtf(SSQ[m] * (1.f / 2048.f) + EPS); float s = 0.f; f32x4 xn[8];
#pragma unroll
                for (int j = 0; j < 4; ++j) { const int col = j * 512 + lane * 8; const u32x4 yw = __builtin_nontemporal_load((const u32x4*)(Y + (size_t)m * 2048 + col));
                    f32x4 x0, x1;
                    if (layer == 0) { x0 = __builtin_nontemporal_load((const f32x4*)(p.x + (size_t)m * 2048 + col)); x1 = __builtin_nontemporal_load((const f32x4*)(p.x + (size_t)m * 2048 + col + 4)); }
                    else { const u32x4 xw = __builtin_nontemporal_load((const u32x4*)(XB + (size_t)m * 2048 + col)); x0 = (f32x4){bflo(xw.x), bfhi(xw.x), bflo(xw.y), bfhi(xw.y)}; x1 = (f32x4){bflo(xw.z), bfhi(xw.z), bflo(xw.w), bfhi(xw.w)}; }
                    const f32x4 g0 = *(const f32x4*)(pg + col), g1 = *(const f32x4*)(pg + col + 4);
                    f32x4 a, bq; a[0] = x0[0] + bflo(yw.x) * rs * g0[0]; a[1] = x0[1] + bfhi(yw.x) * rs * g0[1]; a[2] = x0[2] + bflo(yw.y) * rs * g0[2]; a[3] = x0[3] + bfhi(yw.y) * rs * g0[3];
                    bq[0] = x1[0] + bflo(yw.z) * rs * g1[0]; bq[1] = x1[1] + bfhi(yw.z) * rs * g1[1]; bq[2] = x1[2] + bflo(yw.w) * rs * g1[2]; bq[3] = x1[3] + bfhi(yw.w) * rs * g1[3];
                    xn[2 * j] = a; xn[2 * j + 1] = bq; s += (a[0] * a[0] + a[1] * a[1]) + (a[2] * a[2] + a[3] * a[3]) + (bq[0] * bq[0] + bq[1] * bq[1]) + (bq[2] * bq[2] + bq[3] * bq[3]);
                    if (layer != 0) { __builtin_nontemporal_store(a, (f32x4*)(p.out + (size_t)m * 2048 + col)); __builtin_nontemporal_store(bq, (f32x4*)(p.out + (size_t)m * 2048 + col + 4)); } }
                if (layer == 0) { s = wave_sum(s); if (lane == 0) RSTD[m] = 1.f / sqrtf(s * (1.f / 2048.f) + EPS);
#pragma unroll
                    for (int j = 0; j < 4; ++j) { const f32x4 a = xn[2 * j], bq = xn[2 * j + 1]; u32x4 w; w.x = cvtpk(a[0], a[1]); w.y = cvtpk(a[2], a[3]); w.z = cvtpk(bq[0], bq[1]); w.w = cvtpk(bq[2], bq[3]);
                        *(u32x4*)(XB + (size_t)m * 2048 + j * 512 + lane * 8) = w; } }
            }
        }
        SEAM(kb_ + 5);
    }
#undef IN
#undef SEAM
}

#ifndef MK_MULTI
#define MK_MULTI 0
#endif
constexpr int N_PHASES = 13;
extern "C" void kernel_launch(void* const* d_in, const int* in_sizes, int n_in, void* d_out, int out_size, void* d_ws, size_t ws_size, hipStream_t stream) {
    static int grid = 0;
    if (grid == 0) {
        if (n_in != 18 || ws_size < WS_END) { fprintf(stderr, "kernel_launch: unexpected inputs (n_in %d, ws %zu)\n", n_in, ws_size); grid = -1; return; }
        int dev = 0, cus = 0, per_cu = 0;
        hipGetDevice(&dev); hipDeviceGetAttribute(&cus, hipDeviceAttributeMultiprocessorCount, dev);
        hipFuncSetAttribute((const void*)mega_fwd, hipFuncAttributeMaxDynamicSharedMemorySize, LDS_BYTES);
        if (hipOccupancyMaxActiveBlocksPerMultiprocessor(&per_cu, (const void*)mega_fwd, 512, LDS_BYTES) != hipSuccess || per_cu < 1) per_cu = 1;
        (void)hipGetLastError();
        grid = cus * per_cu;
    }
    if (grid < 0) return;
    Params p{};
    p.x = (const float*)d_in[0]; p.pos = (const int*)d_in[1]; p.pre_g = (const float*)d_in[2]; p.w_in = (const float*)d_in[3];
    p.lq1 = (const float*)d_in[4]; p.lk1 = (const float*)d_in[5]; p.lq2 = (const float*)d_in[6]; p.lk2 = (const float*)d_in[7];
    p.subln_g = (const float*)d_in[8]; p.conv_w = (const float*)d_in[9]; p.conv_b = (const float*)d_in[10]; p.wa = (const float*)d_in[11]; p.ba = (const float*)d_in[12];
    p.wx = (const float*)d_in[13]; p.bx = (const float*)d_in[14]; p.lru_lam = (const float*)d_in[15]; p.w_out = (const float*)d_in[16]; p.post_g = (const float*)d_in[17];
    p.out = (float*)d_out; p.ws = (unsigned char*)d_ws;
#if MK_MULTI
    for (int ph = 0; ph < N_PHASES; ++ph) { p.ph_lo = ph; p.ph_hi = ph + 1; hipLaunchKernelGGL(mega_fwd, dim3(grid), dim3(512), LDS_BYTES, stream, p); }
#else
    p.ph_lo = 0; p.ph_hi = N_PHASES;
    if (hipMemsetAsync((char*)d_ws + WS_BAR, 0, WS_BAR_BYTES, stream) != hipSuccess) { fprintf(stderr, "kernel_launch: memset of barrier words failed\n"); return; }
    void* args[] = {&p};
    hipError_t e = hipLaunchCooperativeKernel((const void*)mega_fwd, dim3(grid), dim3(512), args, LDS_BYTES, stream);
    if (e != hipSuccess) fprintf(stderr, "cooperative launch failed: %s (grid %d)\n", hipGetErrorString(e), grid);
#endif
}
```
